# Optimizing an MI355X kernel written in HIP

```python
import math
import jax
import jax.numpy as jnp
from jax import lax
import numpy as np

D_MODEL = 2048
BATCH = 4
SEQ = 4096
DEPTH = 4

D_MIX = D_MODEL
RET_HEADS = 4
RET_DK = D_MIX // 16
RET_DV = 2 * RET_DK
RET_CHUNK = 128
ROPE_BASE = 10000.0
S5_WIDTH = D_MIX // 4
S5_GROUP = 16
S5_GROUPS = S5_WIDTH // S5_GROUP
S5_STATE = 64
GLA_HEADS = 4
GLA_DV = (D_MIX // 4) // GLA_HEADS
GLA_DK = GLA_DV // 2
GLA_RANK = 16
GLA_TAU = 16.0
GLA_CHUNK = 64
D_FF = 256 * ((8 * D_MODEL // 3 + 255) // 256)
FFN_RES = 0.5
N_MOD = 9
EPS = 1e-6
IN_WIDTHS = (RET_HEADS * RET_DK, RET_HEADS * RET_DK, RET_HEADS * RET_DV, RET_HEADS * RET_DV, S5_WIDTH, GLA_HEADS * GLA_DK, GLA_HEADS * GLA_DK, GLA_HEADS * GLA_DV, GLA_HEADS * GLA_DV, 2 * GLA_RANK)
D_IN = sum(IN_WIDTHS)

kernel_name = "hybrid_parallel_retention_s5_gla_macaron"


def _rms_norm(x, g):
    xf = x.astype(jnp.float32)
    y = xf * lax.rsqrt(jnp.mean(xf * xf, axis=-1, keepdims=True) + EPS)
    return (y * g.astype(jnp.float32)).astype(x.dtype)


def _modulate(h, shift, scale):
    return h * (1.0 + scale[:, None, :]) + shift[:, None, :]


def _swiglu(h, w1, w3, w2):
    return (jax.nn.silu(h @ w1) * (h @ w3)) @ w2


def _head_layer_norm(o):
    mu = jnp.mean(o, axis=-1, keepdims=True)
    oc = o - mu
    return oc * lax.rsqrt(jnp.mean(oc * oc, axis=-1, keepdims=True) + EPS)


def _head_rms_norm(o):
    return o * lax.rsqrt(jnp.mean(o * o, axis=-1, keepdims=True) + EPS)


def _rotary(t, cos, sin):
    t1, t2 = jnp.split(t, 2, axis=-1)
    return jnp.concatenate([t1 * cos - t2 * sin, t1 * sin + t2 * cos], axis=-1)


def _retention_bidir(q, k, v, log_gamma):
    bsz, L, H, dk = q.shape
    dv = v.shape[-1]
    C = RET_CHUNK
    N = L // C
    q = q.reshape(bsz, N, C, H, dk) * (dk ** -0.5)
    k = k.reshape(bsz, N, C, H, dk)
    v = v.reshape(bsz, N, C, H, dv)
    idx = jnp.arange(C, dtype=jnp.float32)
    lg = log_gamma[None, :]
    dist = jnp.abs(idx[:, None] - idx[None, :])
    intra_decay = jnp.exp(dist[None] * log_gamma[:, None, None])
    scores = jnp.einsum('bnihd,bnjhd->bnhij', q, k) * intra_decay
    o = jnp.einsum('bnhij,bnjhe->bnihe', scores, v)
    k_fwd = k * jnp.exp((C - 1.0 - idx)[:, None] * lg)[:, :, None]
    k_bwd = k * jnp.exp(idx[:, None] * lg)[:, :, None]
    kv_fwd = jnp.einsum('bnjhd,bnjhe->nbhde', k_fwd, v)
    kv_bwd = jnp.einsum('bnjhd,bnjhe->nbhde', k_bwd, v)
    gamma_c = jnp.exp(C * log_gamma)[:, None, None]

    def step(s, kv):
        return gamma_c * s + kv, s

    s0 = jnp.zeros((bsz, H, dk, dv), q.dtype)
    _, s_fwd = lax.scan(step, s0, kv_fwd)
    _, s_bwd = lax.scan(step, s0, kv_bwd, reverse=True)
    q_fwd = q * jnp.exp((idx + 1.0)[:, None] * lg)[:, :, None]
    q_bwd = q * jnp.exp((C - idx)[:, None] * lg)[:, :, None]
    o = o + jnp.einsum('bnihd,nbhde->bnihe', q_fwd, s_fwd) + jnp.einsum('bnihd,nbhde->bnihe', q_bwd, s_bwd)
    return o.reshape(bsz, L, H, dv)


def _gla_causal(q, k, v, log_a, include_diag):
    bsz, L, H, dk = q.shape
    dv = v.shape[-1]
    C = GLA_CHUNK
    N = L // C
    q = q.reshape(bsz, N, C, H, dk)
    k = k.reshape(bsz, N, C, H, dk)
    log_a = log_a.reshape(bsz, N, C, H, dk)
    v = v.reshape(bsz, N, C, H, dv)
    b = jnp.cumsum(log_a, axis=2)
    b_last = b[:, :, -1]
    q_in = q * jnp.exp(b)
    k_in = k * jnp.exp(-b)
    scores = jnp.einsum('bnihd,bnjhd->bnhij', q_in, k_in)
    mask = jnp.tril(jnp.ones((C, C), dtype=bool), 0 if include_diag else -1)
    scores = jnp.where(mask, scores, 0.0)
    o = jnp.einsum('bnhij,bnjhe->bnihe', scores, v)
    k_st = k * jnp.exp(b_last[:, :, None] - b)
    kv = jnp.einsum('bnjhd,bnjhe->nbhde', k_st, v)
    decay = jnp.moveaxis(jnp.exp(b_last), 1, 0)[..., None]

    def step(s, inp):
        kv_n, a_n = inp
        return a_n * s + kv_n, s

    _, s_prev = lax.scan(step, jnp.zeros((bsz, H, dk, dv), q.dtype), (kv, decay))
    o = o + jnp.einsum('bnihd,nbhde->bnihe', q_in, s_prev)
    return o.reshape(bsz, L, H, dv)


def _gla_bidir(q, k, v, la_f, la_b):
    flip = lambda t: jnp.flip(t, axis=1)
    o_f = _gla_causal(q, k, v, la_f, True)
    o_b = flip(_gla_causal(flip(q), flip(k), flip(v), flip(la_b), False))
    return o_f + o_b


def _s5_bidir(u, lam_re, lam_im, log_dt, b_re, b_im, c_re, c_im, d_skip):
    f32 = jnp.float32
    bsz, L, W = u.shape
    ug = jnp.moveaxis(u.reshape(bsz, L, S5_GROUPS, S5_GROUP), 1, 0)
    lam = lax.complex(lam_re.astype(f32), lam_im.astype(f32))
    lam_bar = jnp.exp(lam * jnp.exp(log_dt.astype(f32))[..., None])
    b_bar = ((lam_bar - 1.0) / lam)[..., None] * lax.complex(b_re.astype(f32), b_im.astype(f32))
    c_mat = lax.complex(c_re.astype(f32), c_im.astype(f32))

    def combine(e1, e2):
        a1, x1 = e1
        a2, x2 = e2
        return a1 * a2, a2[:, None] * x1 + x2

    y = u * d_skip.astype(f32)
    for direction in range(2):
        bu = jnp.einsum('lbgc,gpc->lbgp', ug, b_bar[direction])
        a = jnp.broadcast_to(lam_bar[direction], (L,) + lam_bar.shape[1:])
        _, states = lax.associative_scan(combine, (a, bu), reverse=(direction == 1), axis=0)
        out = jnp.real(jnp.einsum('gcp,lbgp->lbgc', c_mat[direction], states))
        y = y + jnp.moveaxis(out, 0, 1).reshape(bsz, L, W)
    return y


def _hybrid_mixer(h, w_in, lam_re, lam_im, log_dt, b_re, b_im, c_re, c_im, s5_d, w_glu, b_glu, w_gate, b_gate, w_out):
    f32 = jnp.float32
    bsz, L, _ = h.shape
    pts, acc = [], 0
    for w in IN_WIDTHS[:-1]:
        acc += w
        pts.append(acc)
    proj = (h @ w_in).astype(f32)
    rq, rk, rv, rg, su, gq, gk, gv, gr, glr = jnp.split(proj, pts, axis=-1)
    pos = jnp.arange(L, dtype=f32)
    inv_freq = ROPE_BASE ** (-jnp.arange(0, RET_DK, 2, dtype=f32) / RET_DK)
    ang = pos[:, None] * inv_freq[None, :]
    cos, sin = jnp.cos(ang)[:, None, :], jnp.sin(ang)[:, None, :]
    rq = _rotary(rq.reshape(bsz, L, RET_HEADS, RET_DK), cos, sin)
    rk = _rotary(rk.reshape(bsz, L, RET_HEADS, RET_DK), cos, sin)
    rv = rv.reshape(bsz, L, RET_HEADS, RET_DV)
    log_gamma = jnp.log1p(-jnp.exp2(-5.0 - jnp.arange(RET_HEADS, dtype=f32)))
    o_ret = _retention_bidir(rq, rk, rv, log_gamma)
    y_ret = jax.nn.silu(rg) * _head_layer_norm(o_ret).reshape(bsz, L, RET_HEADS * RET_DV)
    y_s5 = _s5_bidir(su, lam_re, lam_im, log_dt, b_re, b_im, c_re, c_im, s5_d)
    z = jax.nn.gelu(y_s5)
    y_s5 = z * jax.nn.sigmoid(z @ w_glu.astype(f32) + b_glu.astype(f32))
    lr_f, lr_b = jnp.split(glr, 2, axis=-1)
    w_gate = w_gate.astype(f32)
    b_gate = b_gate.astype(f32)
    la_f = (jax.nn.log_sigmoid(lr_f @ w_gate[0] + b_gate[0]) / GLA_TAU).reshape(bsz, L, GLA_HEADS, GLA_DK)
    la_b = (jax.nn.log_sigmoid(lr_b @ w_gate[1] + b_gate[1]) / GLA_TAU).reshape(bsz, L, GLA_HEADS, GLA_DK)
    gq = gq.reshape(bsz, L, GLA_HEADS, GLA_DK) * (GLA_DK ** -0.5)
    gk = gk.reshape(bsz, L, GLA_HEADS, GLA_DK)
    gv = gv.reshape(bsz, L, GLA_HEADS, GLA_DV)
    o_gla = _gla_bidir(gq, gk, gv, la_f, la_b)
    y_gla = jax.nn.silu(gr) * _head_rms_norm(o_gla).reshape(bsz, L, GLA_HEADS * GLA_DV)
    y = jnp.concatenate([y_ret, y_s5, y_gla], axis=-1).astype(h.dtype)
    return y @ w_out


def setup_inputs(seed: int = 0) -> dict:
    key = jax.random.key(seed)
    ks = jax.random.split(key, 28)
    f32 = jnp.float32

    def nrm(k, shape, s):
        return jax.random.normal(k, shape, f32) * s

    G, P, Cg = S5_GROUPS, S5_STATE, S5_GROUP
    x = nrm(ks[0], (BATCH, SEQ, D_MODEL), 1.0)
    c = nrm(ks[1], (BATCH, D_MODEL), 1.0)
    w_ada = nrm(ks[2], (DEPTH, D_MODEL, N_MOD * D_MODEL), 0.5 * D_MODEL ** -0.5)
    b_ada = nrm(ks[3], (DEPTH, N_MOD * D_MODEL), 0.01)
    g_ffn1 = 1.0 + nrm(ks[4], (DEPTH, D_MODEL), 0.01)
    ffn1_w1 = nrm(ks[5], (DEPTH, D_MODEL, D_FF), D_MODEL ** -0.5)
    ffn1_w3 = nrm(ks[6], (DEPTH, D_MODEL, D_FF), D_MODEL ** -0.5)
    ffn1_w2 = nrm(ks[7], (DEPTH, D_FF, D_MODEL), D_FF ** -0.5)
    g_mix = 1.0 + nrm(ks[8], (DEPTH, D_MODEL), 0.01)
    w_in = nrm(ks[9], (DEPTH, D_MODEL, D_IN), D_MODEL ** -0.5)
    s5_lam_re = -0.5 + nrm(ks[10], (DEPTH, 2, G, P), 0.01)
    s5_lam_im = math.pi * jnp.arange(P, dtype=f32) + nrm(ks[11], (DEPTH, 2, G, P), 0.01)
    s5_log_dt = jax.random.uniform(ks[12], (DEPTH, 2, G), f32, math.log(1e-3), math.log(1e-1))
    s5_b_re = nrm(ks[13], (DEPTH, 2, G, P, Cg), (2 * Cg) ** -0.5)
    s5_b_im = nrm(ks[14], (DEPTH, 2, G, P, Cg), (2 * Cg) ** -0.5)
    s5_c_re = nrm(ks[15], (DEPTH, 2, G, Cg, P), P ** -0.5)
    s5_c_im = nrm(ks[16], (DEPTH, 2, G, Cg, P), P ** -0.5)
    s5_d = nrm(ks[17], (DEPTH, S5_WIDTH), 1.0)
    s5_w_glu = nrm(ks[18], (DEPTH, S5_WIDTH, S5_WIDTH), S5_WIDTH ** -0.5)
    s5_b_glu = nrm(ks[19], (DEPTH, S5_WIDTH), 0.01)
    gla_w_gate = nrm(ks[20], (DEPTH, 2, GLA_RANK, GLA_HEADS * GLA_DK), GLA_RANK ** -0.5)
    gla_b_gate = nrm(ks[21], (DEPTH, 2, GLA_HEADS * GLA_DK), 0.01)
    w_out = nrm(ks[22], (DEPTH, D_MIX, D_MODEL), D_MIX ** -0.5)
    g_ffn2 = 1.0 + nrm(ks[23], (DEPTH, D_MODEL), 0.01)
    ffn2_w1 = nrm(ks[24], (DEPTH, D_MODEL, D_FF), D_MODEL ** -0.5)
    ffn2_w3 = nrm(ks[25], (DEPTH, D_MODEL, D_FF), D_MODEL ** -0.5)
    ffn2_w2 = nrm(ks[26], (DEPTH, D_FF, D_MODEL), D_FF ** -0.5)
    g_final = 1.0 + nrm(ks[27], (D_MODEL,), 0.01)
    return {"x": x, "c": c, "w_ada": w_ada, "b_ada": b_ada, "g_ffn1": g_ffn1, "ffn1_w1": ffn1_w1, "ffn1_w3": ffn1_w3, "ffn1_w2": ffn1_w2, "g_mix": g_mix, "w_in": w_in, "s5_lam_re": s5_lam_re, "s5_lam_im": s5_lam_im, "s5_log_dt": s5_log_dt, "s5_b_re": s5_b_re, "s5_b_im": s5_b_im, "s5_c_re": s5_c_re, "s5_c_im": s5_c_im, "s5_d": s5_d, "s5_w_glu": s5_w_glu, "s5_b_glu": s5_b_glu, "gla_w_gate": gla_w_gate, "gla_b_gate": gla_b_gate, "w_out": w_out, "g_ffn2": g_ffn2, "ffn2_w1": ffn2_w1, "ffn2_w3": ffn2_w3, "ffn2_w2": ffn2_w2, "g_final": g_final}


def reference(x, c, w_ada, b_ada, g_ffn1, ffn1_w1, ffn1_w3, ffn1_w2, g_mix, w_in, s5_lam_re, s5_lam_im, s5_log_dt, s5_b_re, s5_b_im, s5_c_re, s5_c_im, s5_d, s5_w_glu, s5_b_glu, gla_w_gate, gla_b_gate, w_out, g_ffn2, ffn2_w1, ffn2_w3, ffn2_w2, g_final):
    h = x
    cond = jax.nn.silu(c)
    for l in range(DEPTH):
        mod = cond @ w_ada[l] + b_ada[l]
        sh1, sc1, gt1, sh2, sc2, gt2, sh3, sc3, gt3 = jnp.split(mod, N_MOD, axis=-1)
        u = _modulate(_rms_norm(h, g_ffn1[l]), sh1, sc1)
        h = h + FFN_RES * gt1[:, None, :] * _swiglu(u, ffn1_w1[l], ffn1_w3[l], ffn1_w2[l])
        u = _modulate(_rms_norm(h, g_mix[l]), sh2, sc2)
        h = h + gt2[:, None, :] * _hybrid_mixer(u, w_in[l], s5_lam_re[l], s5_lam_im[l], s5_log_dt[l], s5_b_re[l], s5_b_im[l], s5_c_re[l], s5_c_im[l], s5_d[l], s5_w_glu[l], s5_b_glu[l], gla_w_gate[l], gla_b_gate[l], w_out[l])
        u = _modulate(_rms_norm(h, g_ffn2[l]), sh3, sc3)
        h = h + FFN_RES * gt3[:, None, :] * _swiglu(u, ffn2_w1[l], ffn2_w3[l], ffn2_w2[l])
    return _rms_norm(h, g_final)
```

```cpp
#ifndef MK_MODE
#define MK_MODE 0
#endif
#include <hip/hip_runtime.h>
#include <cstdio>
#include <cstdint>
namespace pg8 {
#define PG8_LAS __attribute__((address_space(3)))
typedef unsigned short bf16_t;
typedef short bf16x8 __attribute__((ext_vector_type(8)));
typedef float f32x4 __attribute__((ext_vector_type(4)));
typedef unsigned u32x4 __attribute__((ext_vector_type(4)));
constexpr int BM = 256, BK = 64, HALF = 128, HTB = HALF * BK * 2  , STAGE_BYTES = 8 * HTB, NXCD = 8, WGM = 8;

__host__ __device__ __forceinline__ int lds_byte(int r, int c) { const int st = (r >> 4) * 2 + (c >> 5), rr = r & 15, cc = c & 31, ob = rr * 64 + cc * 2; return st * 1024 + (ob ^ (((ob >> 9) & 1) << 5)); }
__host__ __device__ __forceinline__ void stage_rc(int b, int& R, int& C) { const int st = b / 1024, sb = b % 1024, swz = sb ^ (((sb >> 9) & 1) << 5); R = (st >> 1) * 16 + swz / 64; C = (st & 1) * 32 + (swz % 64) / 2; }
__host__ __device__ __forceinline__ int perm32(int rho) { const int n = rho >> 4, i = rho & 15; return 8 * (i >> 2) + 4 * n + (i & 3); }

struct Unit { int pm, pn; };
struct Gemm { const bf16_t* A; const bf16_t* Bt; int M, N, K; };

struct StaticOrder {
    int nM, nN, nwg, G, c;
    __host__ __device__ void init(int M, int N, int G_, int c_) { nM = M / BM; nN = N / BM; nwg = nM * nN; G = G_; c = c_; }
    __host__ __device__ bool next(int i, Unit& u) const {
        const long L = (long)i * G + c; if (L >= nwg) return false;
        int wgid = (int)L; { const int q = nwg / NXCD, r = nwg % NXCD, xcd = wgid % NXCD, off = wgid / NXCD; wgid = (xcd < r ? xcd * (q + 1) : r * (q + 1) + (xcd - r) * q) + off; }
        const int nig = WGM * nN, gid = wgid / nig, fm = gid * WGM, gsz = (nM - fm) < WGM ? (nM - fm) : WGM;
        u.pm = fm + ((wgid % nig) % gsz); u.pn = (wgid % nig) / gsz; return true;
    }
    __device__ __forceinline__ void a_ready(const Unit&) const {}
    __device__ __forceinline__ void done(const Unit&) const {}
};

__device__ __forceinline__ unsigned cvt_pk_bf16(float lo, float hi) { unsigned r; asm volatile("v_cvt_pk_bf16_f32 %0, %1, %2" : "=v"(r) : "v"(lo), "v"(hi)); return r; }
typedef float f32x2 __attribute__((ext_vector_type(2)));
__device__ __forceinline__ float fast_sigmoid(float a) { return __builtin_amdgcn_rcpf(1.0f + __expf(-a)); }
struct EpiPlain {
    static constexpr bool PERM = true, AFTER_DRAIN = false;
    bf16_t* O; int ldc;
    __device__ __forceinline__ void operator()(const f32x4 (&acc)[2][2][4][2], const Unit& u, int wr, int wc, int fr, int fq) const {
        const int row0 = u.pm * BM + wr * 64 + fr, col0 = u.pn * BM + wc * 32 + 8 * fq;
#pragma unroll
        for (int ai = 0; ai < 2; ++ai)
#pragma unroll
            for (int m = 0; m < 4; ++m) { bf16_t* rowp = O + (size_t)(row0 + ai * HALF + m * 16) * ldc + col0;
#pragma unroll
                for (int bj = 0; bj < 2; ++bj) { const f32x4 v0 = acc[ai][bj][m][0], v1 = acc[ai][bj][m][1];
                    u32x4 w; w.x = cvt_pk_bf16(v0[0], v0[1]); w.y = cvt_pk_bf16(v0[2], v0[3]); w.z = cvt_pk_bf16(v1[0], v1[1]); w.w = cvt_pk_bf16(v1[2], v1[3]);
                    *(u32x4*)(rowp + bj * HALF) = w; } }
    }
};
struct EpiSwiGLU {
    static constexpr bool PERM = true, AFTER_DRAIN = false;
    bf16_t* O; int ldc;
    __device__ __forceinline__ void operator()(const f32x4 (&acc)[2][2][4][2], const Unit& u, int wr, int wc, int fr, int fq) const {
        const int row0 = u.pm * BM + wr * 64 + fr, col0 = u.pn * HALF + wc * 32 + 8 * fq;
#pragma unroll
        for (int ai = 0; ai < 2; ++ai)
#pragma unroll
            for (int m = 0; m < 4; ++m) { bf16_t* rowp = O + (size_t)(row0 + ai * HALF + m * 16) * ldc + col0;
                float r[8];
#pragma unroll
                for (int n = 0; n < 2; ++n)
#pragma unroll
                    for (int j = 0; j < 4; ++j) { const float a = acc[ai][0][m][n][j], b = acc[ai][1][m][n][j]; r[n * 4 + j] = a * fast_sigmoid(a) * b; }
                u32x4 w; w.x = cvt_pk_bf16(r[0], r[1]); w.y = cvt_pk_bf16(r[2], r[3]); w.z = cvt_pk_bf16(r[4], r[5]); w.w = cvt_pk_bf16(r[6], r[7]);
                *(u32x4*)rowp = w; }
    }
};
struct EpiResid {
    static constexpr bool PERM = false, AFTER_DRAIN = false;
    const float* base; float* out; int ldc; const float* gate; int gstride; float coef;
    __device__ __forceinline__ void operator()(const f32x4 (&acc)[2][2][4][2], const Unit& u, int wr, int wc, int fr, int fq) const {
        const int row0 = u.pm * BM + wr * 64 + fr, col0 = u.pn * BM + wc * 32 + 4 * fq;
        const float* gp = gate + (size_t)(u.pm >> 4) * gstride + col0;
        f32x4 gv[2][2];
#pragma unroll
        for (int bj = 0; bj < 2; ++bj)
#pragma unroll
            for (int n = 0; n < 2; ++n) gv[bj][n] = *(const f32x4*)(gp + bj * HALF + n * 16) * coef;
#pragma unroll
        for (int ai = 0; ai < 2; ++ai)
#pragma unroll
            for (int m = 0; m < 4; ++m) { const size_t off = (size_t)(row0 + ai * HALF + m * 16) * ldc + col0;
#pragma unroll
                for (int bj = 0; bj < 2; ++bj)
#pragma unroll
                    for (int n = 0; n < 2; ++n) { const f32x4 bs = *(const f32x4*)(base + off + bj * HALF + n * 16);
                        *(f32x4*)(out + off + bj * HALF + n * 16) = bs + gv[bj][n] * acc[ai][bj][m][n]; }
                asm volatile("" ::: "memory"); }
    }
};
struct EpiGlu {
    static constexpr bool PERM = true, AFTER_DRAIN = false;
    const bf16_t* Z; int ldz; bf16_t* Y; int ldy; int ycol0; const float* bias;
    __device__ __forceinline__ void operator()(const f32x4 (&acc)[2][2][4][2], const Unit& u, int wr, int wc, int fr, int fq) const {
        const int row0 = u.pm * BM + wr * 64 + fr, col0 = u.pn * BM + wc * 32 + 8 * fq;
        f32x4 bv[2][2];
#pragma unroll
        for (int bj = 0; bj < 2; ++bj)
#pragma unroll
            for (int n = 0; n < 2; ++n) bv[bj][n] = *(const f32x4*)(bias + col0 + bj * HALF + 4 * n);
#pragma unroll
        for (int ai = 0; ai < 2; ++ai)
#pragma unroll
            for (int m = 0; m < 4; ++m) { const size_t r = (size_t)(row0 + ai * HALF + m * 16);
#pragma unroll
                for (int bj = 0; bj < 2; ++bj) { const u32x4 zz = *(const u32x4*)(Z + r * ldz + col0 + bj * HALF);
                    const f32x4 v0 = acc[ai][bj][m][0] + bv[bj][0], v1 = acc[ai][bj][m][1] + bv[bj][1];
                    float o[8];
#pragma unroll
                    for (int j = 0; j < 4; ++j) { const unsigned zw = zz[j]; const float zl = __uint_as_float(zw << 16), zh = __uint_as_float(zw & 0xffff0000u);
                        const float g0 = (j < 2) ? v0[2 * j] : v1[2 * j - 4], g1 = (j < 2) ? v0[2 * j + 1] : v1[2 * j - 3];
                        o[2 * j] = zl * fast_sigmoid(g0); o[2 * j + 1] = zh * fast_sigmoid(g1); }
                    u32x4 w; w.x = cvt_pk_bf16(o[0], o[1]); w.y = cvt_pk_bf16(o[2], o[3]); w.z = cvt_pk_bf16(o[4], o[5]); w.w = cvt_pk_bf16(o[6], o[7]);
                    *(u32x4*)(Y + r * ldy + ycol0 + col0 + bj * HALF) = w; }
                asm volatile("" ::: "memory"); }
    }
};
template <class Epi, class Sched, bool ALIGN_EPI = false, bool SP2 = false>
__device__ __forceinline__ void gemm_phase(PG8_LAS unsigned char* lds, const Gemm g, const Sched& S, const Epi& E) {
    int tid_ = threadIdx.x; asm volatile("" : "+v"(tid_));
    const int tid = tid_, wid = __builtin_amdgcn_readfirstlane(tid >> 6), lane = tid & 63, wr = wid >> 2, wc = wid & 3, fr = lane & 15, fq = lane >> 4;
    const int K = g.K, nt = K / BK;
    unsigned voffA[2], voffB[2];
#pragma unroll
    for (int i = 0; i < 2; ++i) { int R, C; stage_rc(tid * 16 + i * 8192, R, C); const int Rb = Epi::PERM ? ((R & ~31) + perm32(R & 31)) : R;
        voffA[i] = (unsigned)(R * K + C) * 2u; voffB[i] = (unsigned)(Rb * K + C) * 2u; }
    const size_t kstep = (size_t)(BK * 2);
    const size_t hstep = (size_t)HALF * K * 2;
    const size_t tstep = 2 * hstep;
    const unsigned ldsw = (unsigned)wid * 1024u;
    const int aoff = lds_byte(wr * 64 + fr, fq * 8), boff = lds_byte(wc * 32 + fr, fq * 8);
#define PG8_SA(b, h) (((b) * 2 + (h)) * HTB)
#define PG8_SB(b, h) ((4 + (b) * 2 + (h)) * HTB)
#define PG8_STAGE(bufoff, gbase, voff) do { _Pragma("unroll") for (int _i = 0; _i < 2; ++_i) \
        __builtin_amdgcn_global_load_lds((const unsigned*)((const char*)(gbase) + (voff)[_i]), (PG8_LAS unsigned*)(lds + (bufoff) + ldsw + _i * 8192), 16, 0, 0); } while (0)
#define PG8_LDA(dst, b, h) do { _Pragma("unroll") for (int m = 0; m < 4; ++m) _Pragma("unroll") for (int k = 0; k < 2; ++k) dst[m][k] = *(const PG8_LAS bf16x8*)(lds + PG8_SA(b, h) + aoff + m * 2048 + k * 1024); } while (0)
#define PG8_LDB(dst, b, h) do { _Pragma("unroll") for (int n = 0; n < 2; ++n) _Pragma("unroll") for (int k = 0; k < 2; ++k) dst[n][k] = *(const PG8_LAS bf16x8*)(lds + PG8_SB(b, h) + boff + n * 2048 + k * 1024); } while (0)
#define PG8_MMA(ai, bj, At, Bt) do { __builtin_amdgcn_s_setprio(1); _Pragma("unroll") for (int m = 0; m < 4; ++m) _Pragma("unroll") for (int n = 0; n < 2; ++n) _Pragma("unroll") for (int k = 0; k < 2; ++k) \
        acc[ai][bj][m][n] = __builtin_amdgcn_mfma_f32_16x16x32_bf16(Bt[n][k], At[m][k], acc[ai][bj][m][n], 0, 0, 0); __builtin_amdgcn_s_setprio(0); } while (0)
#define PG8_WAIT_V(n) asm volatile("s_waitcnt vmcnt(" #n ")" ::: "memory")
#define PG8_WAIT_L(n) asm volatile("s_waitcnt lgkmcnt(" #n ")" ::: "memory")
#define PG8_BAR __builtin_amdgcn_s_barrier()
#define PG8_SCHED __builtin_amdgcn_sched_barrier(0)
    Unit cur, nxt; int ui = 0;
    if (!S.next(0, cur)) return;
    f32x4 acc[2][2][4][2];
#pragma unroll
    for (int a = 0; a < 2; ++a)
#pragma unroll
        for (int b = 0; b < 2; ++b)
#pragma unroll
            for (int m = 0; m < 4; ++m)
#pragma unroll
                for (int n = 0; n < 2; ++n) acc[a][b][m][n] = (f32x4){0.f, 0.f, 0.f, 0.f};
    bf16x8 At[4][2], B0[2][2], B1[2][2];
    const char* cA = (const char*)g.A + (size_t)cur.pm * tstep; const char* cB = (const char*)g.Bt + (size_t)cur.pn * tstep;
    S.a_ready(cur);
    if constexpr (SP2) {
        PG8_STAGE(PG8_SB(0, 0), cB, voffB); PG8_STAGE(PG8_SB(0, 1), cB + hstep, voffB); PG8_STAGE(PG8_SA(0, 0), cA, voffA); PG8_STAGE(PG8_SA(0, 1), cA + hstep, voffA);
        if (wr == 1) PG8_BAR;
        PG8_WAIT_V(2); PG8_BAR;
        PG8_STAGE(PG8_SB(1, 0), cB + kstep, voffB); PG8_STAGE(PG8_SA(1, 0), cA + kstep, voffA); PG8_STAGE(PG8_SB(1, 1), cB + hstep + kstep, voffB);
        PG8_WAIT_V(6); PG8_BAR;
    } else {
        PG8_STAGE(PG8_SB(0, 0), cB, voffB); PG8_STAGE(PG8_SA(0, 0), cA, voffA); PG8_STAGE(PG8_SB(0, 1), cB + hstep, voffB); PG8_STAGE(PG8_SA(0, 1), cA + hstep, voffA);
        if (wr == 1) PG8_BAR;
        PG8_WAIT_V(4); PG8_BAR;
        PG8_STAGE(PG8_SB(1, 0), cB + kstep, voffB); PG8_STAGE(PG8_SA(1, 0), cA + kstep, voffA); PG8_STAGE(PG8_SB(1, 1), cB + hstep + kstep, voffB);
        PG8_WAIT_V(6); PG8_BAR;
    }
    for (;;) {
        const bool has_next = S.next(ui + 1, nxt);
        const char* nA = has_next ? (const char*)g.A + (size_t)nxt.pm * tstep : cA; const char* nB = has_next ? (const char*)g.Bt + (size_t)nxt.pn * tstep : cB;
        for (int t = 0; t < nt; t += 2) {
            const bool last = (t == nt - 2);
            const char* a1 = cA + (size_t)(t + 1) * kstep;
            const char* a2 = last ? nA : cA + (size_t)(t + 2) * kstep; const char* b2 = last ? nB : cB + (size_t)(t + 2) * kstep;
            const char* a3 = a2 + kstep; const char* b3 = b2 + kstep;
            if (last && has_next) S.a_ready(nxt);
            if constexpr (SP2) {
            PG8_LDB(B0, 0, 0); PG8_LDB(B1, 0, 1); PG8_SCHED; PG8_LDA(At, 0, 0); PG8_STAGE(PG8_SA(1, 1), a1 + hstep, voffA);
            PG8_WAIT_V(8); PG8_WAIT_L(0); PG8_BAR; PG8_MMA(0, 0, At, B0); PG8_MMA(0, 1, At, B1); PG8_BAR; PG8_SCHED;
            PG8_LDA(At, 0, 1); PG8_STAGE(PG8_SB(0, 0), b2, voffB); PG8_STAGE(PG8_SB(0, 1), b2 + hstep, voffB); PG8_STAGE(PG8_SA(0, 0), a2, voffA);
            PG8_WAIT_V(8); PG8_WAIT_L(0); PG8_BAR; PG8_MMA(1, 0, At, B0); PG8_MMA(1, 1, At, B1); PG8_BAR; PG8_SCHED;
            PG8_LDB(B0, 1, 0); PG8_LDB(B1, 1, 1); PG8_SCHED; PG8_LDA(At, 1, 0); PG8_STAGE(PG8_SA(0, 1), a2 + hstep, voffA);
            PG8_WAIT_V(8); PG8_WAIT_L(0); PG8_BAR; PG8_MMA(0, 0, At, B0); PG8_MMA(0, 1, At, B1); PG8_BAR; PG8_SCHED;
            PG8_LDA(At, 1, 1); PG8_STAGE(PG8_SB(1, 0), b3, voffB); PG8_STAGE(PG8_SB(1, 1), b3 + hstep, voffB); PG8_STAGE(PG8_SA(1, 0), a3, voffA);
            PG8_WAIT_V(8); PG8_WAIT_L(0); PG8_BAR; PG8_MMA(1, 0, At, B0); PG8_MMA(1, 1, At, B1); PG8_BAR; PG8_SCHED;
            } else {
            PG8_LDB(B0, 0, 0); PG8_SCHED; PG8_LDA(At, 0, 0); PG8_STAGE(PG8_SA(1, 1), a1 + hstep, voffA);
            PG8_WAIT_L(8); PG8_BAR; PG8_WAIT_L(0); PG8_MMA(0, 0, At, B0); PG8_BAR; PG8_SCHED;
            PG8_LDB(B1, 0, 1); PG8_STAGE(PG8_SB(0, 0), b2, voffB);
            PG8_BAR; PG8_WAIT_L(0); PG8_MMA(0, 1, At, B1); PG8_BAR;
            PG8_LDA(At, 0, 1); PG8_STAGE(PG8_SA(0, 0), a2, voffA);
            PG8_BAR; PG8_WAIT_L(0); PG8_MMA(1, 0, At, B0); PG8_BAR; PG8_SCHED;
            PG8_STAGE(PG8_SB(0, 1), b2 + hstep, voffB);
            PG8_WAIT_V(6); PG8_BAR; PG8_MMA(1, 1, At, B1); PG8_BAR;
            PG8_LDB(B0, 1, 0); PG8_SCHED; PG8_LDA(At, 1, 0); PG8_STAGE(PG8_SA(0, 1), a2 + hstep, voffA);
            PG8_WAIT_L(8); PG8_BAR; PG8_WAIT_L(0); PG8_MMA(0, 0, At, B0); PG8_BAR; PG8_SCHED;
            PG8_LDB(B1, 1, 1); PG8_STAGE(PG8_SB(1, 0), b3, voffB);
            PG8_BAR; PG8_WAIT_L(0); PG8_MMA(0, 1, At, B1); PG8_BAR;
            PG8_LDA(At, 1, 1); PG8_STAGE(PG8_SA(1, 0), a3, voffA);
            PG8_BAR; PG8_WAIT_L(0); PG8_MMA(1, 0, At, B0); PG8_BAR; PG8_SCHED;
            PG8_STAGE(PG8_SB(1, 1), b3 + hstep, voffB);
            PG8_WAIT_V(6); PG8_BAR; PG8_MMA(1, 1, At, B1); PG8_BAR;
            }
        }
        if constexpr (ALIGN_EPI) { if (wr == 0) PG8_BAR; }
        if constexpr (!Epi::AFTER_DRAIN) { E(acc, cur, wr, wc, fr, fq); S.done(cur); }
        if (!has_next) break;
#pragma unroll
        for (int a = 0; a < 2; ++a)
#pragma unroll
            for (int b = 0; b < 2; ++b)
#pragma unroll
                for (int m = 0; m < 4; ++m)
#pragma unroll
                    for (int n = 0; n < 2; ++n) acc[a][b][m][n] = (f32x4){0.f, 0.f, 0.f, 0.f};
        cur = nxt; cA = nA; cB = nB; ++ui;
        if constexpr (ALIGN_EPI) { if (wr == 1) PG8_BAR; }
    }
    PG8_WAIT_V(0);
    if constexpr (!ALIGN_EPI) { if (wr == 0) PG8_BAR; }
    PG8_BAR;
    if constexpr (Epi::AFTER_DRAIN) { E.fused(acc, cur, wr, wc, fr, fq, lds, wid, lane); S.done(cur); }
#undef PG8_SA
#undef PG8_SB
#undef PG8_STAGE
#undef PG8_LDA
#undef PG8_LDB
#undef PG8_MMA
#undef PG8_WAIT_V
#undef PG8_WAIT_L
#undef PG8_BAR
#undef PG8_SCHED
}
}
#define GAS __attribute__((address_space(1)))
#define LAS __attribute__((address_space(3)))
typedef unsigned short bf16;
typedef unsigned v4u __attribute__((ext_vector_type(4)));
typedef float f32x4 __attribute__((ext_vector_type(4)));
typedef short bf16x8 __attribute__((ext_vector_type(8)));
typedef GAS unsigned gu32;
typedef GAS unsigned long long gu64;
#define RLX_AGENT __ATOMIC_RELAXED, __HIP_MEMORY_SCOPE_AGENT
#define LDS_WAIT() asm volatile("s_waitcnt lgkmcnt(0)" ::: "memory")
#define VM_WAIT() asm volatile("s_waitcnt vmcnt(0)" ::: "memory")
__device__ __forceinline__ unsigned long long rt() { return __builtin_amdgcn_s_memrealtime(); }
__device__ __forceinline__ unsigned f2bf(float f) { unsigned u = __builtin_bit_cast(unsigned, f); return (u + 0x7fffu + ((u >> 16) & 1u)) >> 16; }
__device__ __forceinline__ unsigned pk2(float lo, float hi) { return f2bf(lo) | (f2bf(hi) << 16); }

#define XB_TMO      128
#define XB_XCNT(j)  (256  + 64 * (j))
#define XB_XSUB(j)  (1280 + 64 * (j))
#define XB_XGEN(j)  (2304 + 64 * (j))
#define XB_TOP      3328
#define XB_TOPGEN   3392
#define XCD_BAR_WORDS 3456
#define XB_SPIN_CAP (1u << 18)

__device__ __forceinline__ unsigned xb_ld(unsigned* p)              { return __hip_atomic_load(p, __ATOMIC_RELAXED, __HIP_MEMORY_SCOPE_AGENT); }
__device__ __forceinline__ unsigned xb_add(unsigned* p, unsigned v) { return __hip_atomic_fetch_add(p, v, __ATOMIC_RELAXED, __HIP_MEMORY_SCOPE_AGENT); }
__device__ __forceinline__ unsigned xb_xcc_id() { return (unsigned)__builtin_amdgcn_s_getreg((3 << 11) | 20) & 0xFu; }
#define XB_SPIN(cond, bar) do { unsigned _sp = 0; while (cond) { __builtin_amdgcn_s_sleep(1); \
    if ((++_sp & 255u) == 0u) { if (xb_ld(&(bar)[XB_TMO])) break; if (_sp > XB_SPIN_CAP) { atomicAdd(&(bar)[XB_TMO], 1u); break; } } } } while (0)

struct XcdBarrier {
    unsigned* bar; unsigned x;
    volatile LAS unsigned* st;
};

__device__ __forceinline__ XcdBarrier xcd_barrier_post(unsigned* bar, volatile LAS unsigned* st) {
    XcdBarrier b; b.bar = bar; b.x = xb_xcc_id(); b.st = st;
    if (threadIdx.x == 0) (void)xb_add(&bar[XB_XCNT(b.x)], 1u);
    return b;
}
__device__ __forceinline__ void xcd_barrier_complete(unsigned* bar, unsigned x, unsigned& nloc, unsigned& nx) {
    const unsigned G = gridDim.x * gridDim.y * gridDim.z;
    unsigned sum, cnt, mine, sp = 0u;
    for (;;) {
        sum = 0u; cnt = 0u; mine = 0u;
#pragma unroll
        for (unsigned j = 0; j < 16; ++j) { const unsigned c = xb_ld(&bar[XB_XCNT(j)]); sum += c; cnt += (c > 0u) ? 1u : 0u; mine = (j == x) ? c : mine; }
        if (sum == G) break;
        __builtin_amdgcn_s_sleep(1);
        if ((++sp & 255u) == 0u) { if (xb_ld(&bar[XB_TMO])) break; if (sp > XB_SPIN_CAP) { atomicAdd(&bar[XB_TMO], 1u); break; } }
    }
    nloc = mine > 0u ? mine : 1u; nx = cnt > 0u ? cnt : 1u;
}

__device__ __forceinline__ void xcd_barrier(const XcdBarrier& b) {
    asm volatile("s_waitcnt vmcnt(0)" ::: "memory");
    __syncthreads();
    if (threadIdx.x == 0) {
        unsigned* bar = b.bar;
        __builtin_amdgcn_s_waitcnt(0);
        unsigned nloc = b.st[0], nx = b.st[1];
        if (nloc == 0u) { xcd_barrier_complete(bar, b.x, nloc, nx); b.st[0] = nloc; b.st[1] = nx; }
        const unsigned old = xb_add(&bar[XB_XSUB(b.x)], 1u);
        const unsigned gen = old / nloc;
        if (old + 1u == (gen + 1u) * nloc) {
            __builtin_amdgcn_fence(__ATOMIC_RELEASE, "agent");
            asm volatile("s_waitcnt vmcnt(0)" ::: "memory");
            const unsigned og = xb_add(&bar[XB_TOP], 1u);
            const unsigned tg = og / nx;
            if (og + 1u == (tg + 1u) * nx) xb_add(&bar[XB_TOPGEN], 1u);
            else XB_SPIN(xb_ld(&bar[XB_TOPGEN]) == tg, bar);
            __builtin_amdgcn_fence(__ATOMIC_ACQUIRE, "agent");
            xb_add(&bar[XB_XGEN(b.x)], 1u);
            asm volatile("s_waitcnt vmcnt(0)" ::: "memory");
        } else {
            XB_SPIN(xb_ld(&bar[XB_XGEN(b.x)]) == gen, bar);
            __builtin_amdgcn_fence(__ATOMIC_ACQUIRE, "agent");
            asm volatile("s_waitcnt vmcnt(0)" ::: "memory");
        }
    }
    __syncthreads();
}
constexpr int NWAVES = 8;
constexpr int BATCH = 4, SEQ = 4096, D = 2048, DEPTH = 4, M = BATCH * SEQ, FF = 5632, NIN = 5152, NINP = 5376, NMOD = 9, MODW = NMOD * D;
constexpr int RET_H = 4, RET_DK = 128, RET_DV = 256, S5_W = 512, S5_G = 32, S5_P = 64, S5_C = 16, GLA_H = 4, GLA_DK = 64, GLA_DV = 128, GLA_R = 16;
constexpr int PC_RQ = 0, PC_RK = 512, PC_RV = 1024, PC_RG = 2048, PC_SU = 3072, PC_GQ = 3584, PC_GK = 3840, PC_GV = 4096, PC_GR = 4608, PC_LR = 5120;
constexpr float EPS = 1e-6f;
constexpr size_t MiB = 1u << 20;
constexpr size_t WS_CTL = 0, CTL_ZERO_BYTES = 2 * MiB;
constexpr size_t WS_MOD = 2 * MiB;
constexpr size_t WS_ROT = 4 * MiB;
constexpr size_t WS_S5L = 6 * MiB;
constexpr size_t WS_S5B = 7 * MiB;
constexpr size_t WS_LA = 16 * MiB;
constexpr size_t WS_H = 48 * MiB;
constexpr size_t WS_U = 176 * MiB;
constexpr size_t WS_Y = 240 * MiB;
constexpr size_t WS_Z = 304 * MiB;
constexpr size_t WS_G = 320 * MiB;
constexpr size_t WS_PROJ = 496 * MiB;
constexpr size_t WS_ORET = 664 * MiB;
constexpr size_t WS_OGLA = 728 * MiB;
constexpr size_t WS_YS5 = 760 * MiB;
constexpr size_t WS_W = 800 * MiB;
constexpr size_t LW_13A = 0, LW_2A = 44 * MiB, LW_IN = 66 * MiB, LW_OUT = 87 * MiB, LW_GLU = 95 * MiB, LW_13B = 96 * MiB, LW_2B = 140 * MiB, LW_STRIDE = 162 * MiB;
constexpr size_t WS_END = WS_W + DEPTH * LW_STRIDE;
constexpr int CW_BAR = 4096;
constexpr int MAX_BAR_REGIONS = 128;
constexpr int RING_OFF = 0, RING_BYTES = 131072;
constexpr int LDSCTL_OFF = RING_BYTES, MISC_OFF = LDSCTL_OFF + 320;
constexpr int LDS_BYTES = 147456;

struct Frame {
    LAS unsigned char* lds;
    volatile LAS unsigned* MISC;
    gu32* ctl;
    int tid, lane, wave;
    int vcu, G;
};

__device__ __forceinline__ float wave_sum(float v) {
#pragma unroll
    for (int o = 1; o < 64; o <<= 1) v += __shfl_xor(v, o);
    return v;
}
__device__ __forceinline__ float wave_sum_l(float v, int lane) {
#pragma unroll
    for (int o = 1; o < 64; o <<= 1) v += __int_as_float(__builtin_amdgcn_ds_bpermute((lane ^ o) << 2, __float_as_int(v)));
    return v;
}
__device__ __forceinline__ float bf2f(bf16 b) { return __uint_as_float(((unsigned)b) << 16); }

__device__ __forceinline__ void p0_transpose_item(const float* W, int K, int N, bf16* WT, int rowbase, int k0, int n0, LAS float* scr, int lane) {
#pragma unroll 8
    for (int i = 0; i < 32; ++i) { const int kk = 2 * i + (lane >> 5); scr[kk * 33 + (lane & 31)] = W[(size_t)(k0 + kk) * N + n0 + (lane & 31)]; }
    LDS_WAIT(); asm volatile("" ::: "memory");
    const int c = lane & 7;
#pragma unroll
    for (int j = 0; j < 4; ++j) { const int n = (lane >> 3) + 8 * j; const LAS float* s = scr + (8 * c) * 33 + n;
        v4u o; o.x = pk2(s[0 * 33], s[1 * 33]); o.y = pk2(s[2 * 33], s[3 * 33]); o.z = pk2(s[4 * 33], s[5 * 33]); o.w = pk2(s[6 * 33], s[7 * 33]);
        *(GAS v4u*)(WT + (size_t)(rowbase + n) * K + k0 + 8 * c) = o; }
    LDS_WAIT(); asm volatile("" ::: "memory");
}

struct Args {
    const float* in[28]; float* out; unsigned char* ws;
    int ph_lo, ph_hi, li, pad;
};
typedef const __attribute__((address_space(4))) Args* KArgsP;
__device__ __forceinline__ KArgsP kargs() { KArgsP p = (KArgsP)__builtin_amdgcn_kernarg_segment_ptr(); asm volatile("" : "+s"(p)); return p; }
#define WSP(off) ((unsigned char*)kargs()->ws + (off))
#define INP(i) ((const float*)kargs()->in[i])
enum { I_X = 0, I_C, I_WADA, I_BADA, I_GFFN1, I_F1W1, I_F1W3, I_F1W2, I_GMIX, I_WIN, I_LRE, I_LIM, I_LDT, I_BRE, I_BIM, I_CRE, I_CIM, I_S5D, I_WGLU, I_BGLU, I_WGATE, I_BGATE, I_WOUT, I_GFFN2, I_F2W1, I_F2W3, I_F2W2, I_GFINAL };

__device__ __forceinline__ void p0_prologue(Frame& F) {
    unsigned char* ws = (unsigned char*)kargs()->ws;
    {
        LAS float* cond = (LAS float*)(F.lds + RING_OFF);
        LAS float* red = (LAS float*)(F.lds + RING_OFF + 32768);
        const float* c = kargs()->in[I_C];
        for (int i = F.tid; i < BATCH * D; i += NWAVES * 64) { const int b = i / D, k = i % D; const float v = c[i]; cond[k * 4 + b] = v / (1.0f + __expf(-v)); }
        __syncthreads();
        float* mod = (float*)(ws + WS_MOD);
        constexpr int NCB = MODW / 64;
        for (int it = F.vcu; it < DEPTH * NCB; it += F.G) {
            const int l = it / NCB, j0 = (it % NCB) * 64;
            const float* W = kargs()->in[I_WADA] + (size_t)l * D * MODW + j0 + F.lane;
            float acc0 = 0.f, acc1 = 0.f, acc2 = 0.f, acc3 = 0.f;
            const int kb = F.wave * 256;
#pragma unroll 8
            for (int k = 0; k < 256; ++k) { const float w = W[(size_t)(kb + k) * MODW]; const f32x4 cv = *(const LAS f32x4*)(cond + (kb + k) * 4);
                acc0 += cv[0] * w; acc1 += cv[1] * w; acc2 += cv[2] * w; acc3 += cv[3] * w; }
            red[(F.wave * 4 + 0) * 64 + F.lane] = acc0; red[(F.wave * 4 + 1) * 64 + F.lane] = acc1; red[(F.wave * 4 + 2) * 64 + F.lane] = acc2; red[(F.wave * 4 + 3) * 64 + F.lane] = acc3;
            __syncthreads();
            if (F.tid < 256) { const int b = F.tid >> 6, col = F.tid & 63; float s = 0.f;
#pragma unroll
                for (int w = 0; w < 8; ++w) s += red[(w * 4 + b) * 64 + col];
                mod[((size_t)l * BATCH + b) * MODW + j0 + col] = s + kargs()->in[I_BADA][(size_t)l * MODW + j0 + col]; }
            __syncthreads();
        }
    }
    __syncthreads();
    const int gw = F.vcu * NWAVES + F.wave, NGW = F.G * NWAVES;
    const int gt = gw * 64 + F.lane, NGT = NGW * 64;
    {
        float* rc = (float*)(ws + WS_ROT); float* rs = rc + SEQ * 64;
        for (int i = gt; i < SEQ * 64; i += NGT) { const int pos = i >> 6, j = i & 63; const float invf = powf(10000.0f, -(float)(2 * j) / 128.0f); const float ang = (float)pos * invf; rc[i] = cosf(ang); rs[i] = sinf(ang); }
    }
    {
        float* lb = (float*)(ws + WS_S5L); float* bb = (float*)(ws + WS_S5B);
        for (int i = gt; i < DEPTH * 2 * S5_G * S5_P; i += NGT) {
            const int ldg = i / S5_P;
            const float lre = kargs()->in[I_LRE][i], lim = kargs()->in[I_LIM][i], dt = expf(kargs()->in[I_LDT][ldg]);
            const float zr = lre * dt, zi = lim * dt, e = expf(zr); const float br = e * cosf(zi), bi = e * sinf(zi);
            lb[2 * i] = br; lb[2 * i + 1] = bi;
            const float nr = br - 1.0f, ni = bi, den = lre * lre + lim * lim; const float cr = (nr * lre + ni * lim) / den, ci = (ni * lre - nr * lim) / den;
#pragma unroll
            for (int c = 0; c < S5_C; ++c) { const float xr = kargs()->in[I_BRE][(size_t)i * S5_C + c], xi = kargs()->in[I_BIM][(size_t)i * S5_C + c];
                bb[((size_t)i * S5_C + c) * 2] = cr * xr - ci * xi; bb[((size_t)i * S5_C + c) * 2 + 1] = cr * xi + ci * xr; }
        }
    }
    {
        LAS float* scr = (LAS float*)(F.lds + RING_OFF + F.wave * 16384);
        constexpr int I_FF = (D / 64) * (FF / 32);
        constexpr int I_W2 = (FF / 64) * (D / 32);
        constexpr int I_IN = (D / 64) * (NIN / 32);
        constexpr int I_OUT = (D / 64) * (D / 32);
        constexpr int I_GLU = (S5_W / 64) * (S5_W / 32);
        constexpr int PER_L = 4 * I_FF + 2 * I_W2 + I_IN + I_OUT + I_GLU;
        for (int it = gw; it < DEPTH * PER_L; it += NGW) {
            const int l = it / PER_L; int r = it % PER_L;
            unsigned char* wl = ws + WS_W + (size_t)l * LW_STRIDE;
            const float* W; int K, N; bf16* WT; int mode = 0;
            if (r < I_FF) { W = kargs()->in[I_F1W1] + (size_t)l * D * FF; K = D; N = FF; WT = (bf16*)(wl + LW_13A); mode = 1; }
            else if ((r -= I_FF) < I_FF) { W = kargs()->in[I_F1W3] + (size_t)l * D * FF; K = D; N = FF; WT = (bf16*)(wl + LW_13A); mode = 2; }
            else if ((r -= I_FF) < I_W2) { W = kargs()->in[I_F1W2] + (size_t)l * FF * D; K = FF; N = D; WT = (bf16*)(wl + LW_2A); }
            else if ((r -= I_W2) < I_FF) { W = kargs()->in[I_F2W1] + (size_t)l * D * FF; K = D; N = FF; WT = (bf16*)(wl + LW_13B); mode = 1; }
            else if ((r -= I_FF) < I_FF) { W = kargs()->in[I_F2W3] + (size_t)l * D * FF; K = D; N = FF; WT = (bf16*)(wl + LW_13B); mode = 2; }
            else if ((r -= I_FF) < I_W2) { W = kargs()->in[I_F2W2] + (size_t)l * FF * D; K = FF; N = D; WT = (bf16*)(wl + LW_2B); }
            else if ((r -= I_W2) < I_IN) { W = kargs()->in[I_WIN] + (size_t)l * D * NIN; K = D; N = NIN; WT = (bf16*)(wl + LW_IN); }
            else if ((r -= I_IN) < I_OUT) { W = kargs()->in[I_WOUT] + (size_t)l * D * D; K = D; N = D; WT = (bf16*)(wl + LW_OUT); }
            else { r -= I_OUT; W = kargs()->in[I_WGLU] + (size_t)l * S5_W * S5_W; K = S5_W; N = S5_W; WT = (bf16*)(wl + LW_GLU); }
            const int nblk = N / 32, kb = r / nblk, nb = r % nblk, k0 = 64 * kb, n0 = 32 * nb;
            int rowbase = n0;
            if (mode) rowbase = 256 * (n0 / 128) + (n0 % 128) + (mode == 2 ? 128 : 0);
            p0_transpose_item(W, K, N, WT, rowbase, k0, n0, scr, F.lane);
        }
        constexpr int PADV = (NINP - NIN) * D * 2 / 16;
        for (int i = gt; i < DEPTH * PADV; i += NGT) { const int l = i / PADV, r = i % PADV;
            *(GAS v4u*)(ws + WS_W + (size_t)l * LW_STRIDE + LW_IN + (size_t)NIN * D * 2 + (size_t)r * 16) = (v4u){0u, 0u, 0u, 0u}; }
    }
}

__device__ __forceinline__ void norm_mod_phase(Frame& F, const float* src, const float* g, const float* shift, const float* scale, bf16* U) {
    int lane = F.lane; asm volatile("" : "+v"(lane));
    const int gw = F.vcu * NWAVES + F.wave, NGW = F.G * NWAVES;
    for (int m = gw; m < M; m += NGW) {
        const int b = m / SEQ;
        const GAS f32x4* xr = (const GAS f32x4*)(src + (size_t)m * D) + lane;
        f32x4 v[8]; float s = 0.f;
#pragma unroll
        for (int j = 0; j < 8; ++j) { v[j] = xr[64 * j]; s += (v[j].x * v[j].x + v[j].y * v[j].y) + (v[j].z * v[j].z + v[j].w * v[j].w); }
        const float rstd = 1.0f / sqrtf(wave_sum_l(s, lane) * (1.0f / D) + EPS);
        const GAS f32x4* gp = (const GAS f32x4*)g + lane; const GAS f32x4* sh = (const GAS f32x4*)(shift + (size_t)b * MODW) + lane; const GAS f32x4* sc = (const GAS f32x4*)(scale + (size_t)b * MODW) + lane;
        GAS unsigned long long* o8 = (GAS unsigned long long*)(U + (size_t)m * D) + lane;
#pragma unroll
        for (int j = 0; j < 8; ++j) { const f32x4 gg = gp[64 * j], hh = sh[64 * j], cc = sc[64 * j];
            const f32x4 y = (v[j] * rstd) * gg; const f32x4 o = y * (cc + 1.0f) + hh;
            o8[64 * j] = (unsigned long long)pk2(o.x, o.y) | ((unsigned long long)pk2(o.z, o.w) << 32); }
    }
}
__device__ __forceinline__ void final_norm_phase(Frame& F, const float* src, const float* g, float* out) {
    int lane = F.lane; asm volatile("" : "+v"(lane));
    const int gw = F.vcu * NWAVES + F.wave, NGW = F.G * NWAVES;
    for (int m = gw; m < M; m += NGW) {
        const GAS f32x4* xr = (const GAS f32x4*)(src + (size_t)m * D) + lane;
        f32x4 v[8]; float s = 0.f;
#pragma unroll
        for (int j = 0; j < 8; ++j) { v[j] = xr[64 * j]; s += (v[j].x * v[j].x + v[j].y * v[j].y) + (v[j].z * v[j].z + v[j].w * v[j].w); }
        const float rstd = 1.0f / sqrtf(wave_sum_l(s, lane) * (1.0f / D) + EPS);
        const GAS f32x4* gp = (const GAS f32x4*)g + lane; GAS f32x4* o = (GAS f32x4*)(out + (size_t)m * D) + lane;
#pragma unroll
        for (int j = 0; j < 8; ++j) o[64 * j] = (v[j] * rstd) * gp[64 * j];
    }
}
constexpr int NP = 13;
constexpr int PH_FINAL = 1 + DEPTH * NP;
constexpr int PH_END = PH_FINAL + 1;

#define MK_BAR(b) XcdBarrier b; b.bar = (unsigned*)WSP(WS_CTL) + CW_BAR + kargs()->li * XCD_BAR_WORDS; b.x = xb_xcc_id(); b.st = (volatile LAS unsigned*)((LAS unsigned char*)lds + MISC_OFF) + 8
__global__ void __launch_bounds__(NWAVES * 64, 2) mega(Args args_unused) {
    extern __shared__ __attribute__((aligned(16))) unsigned char lds[];
    Frame F;
    F.lds = (LAS unsigned char*)lds;
    F.MISC = (volatile LAS unsigned*)(F.lds + MISC_OFF);
    F.tid = threadIdx.x; F.lane = F.tid & 63; F.wave = __builtin_amdgcn_readfirstlane(F.tid >> 6);
    F.G = gridDim.x; { const int bx = blockIdx.x; F.vcu = (F.G % 8 == 0) ? (bx % 8) * (F.G / 8) + bx / 8 : bx; }
    F.ctl = nullptr;
    for (int u = F.tid; u < (LDS_BYTES - LDSCTL_OFF) / 4; u += NWAVES * 64) ((LAS unsigned*)(F.lds + LDSCTL_OFF))[u] = 0u;
    __syncthreads();
    const int lo = kargs()->ph_lo, hi = kargs()->ph_hi;
    if (hi - lo > 1) { (void)xcd_barrier_post((unsigned*)WSP(WS_CTL) + CW_BAR + kargs()->li * XCD_BAR_WORDS, F.MISC + 8); }
#define GRID_BAR() do { MK_BAR(bar_); xcd_barrier(bar_); } while (0)
#define IN(k) (lo <= (k) && (k) < hi)
#define BOTH(k) (IN(k) && IN((k) + 1))
#define LW(l, off) ((const bf16*)(WSP(WS_W) + (size_t)(l) * LW_STRIDE + (off)))
#define MODP(l, k) ((const float*)WSP(WS_MOD) + (size_t)(l) * BATCH * MODW + (k) * D)
#define HP ((float*)WSP(WS_H))
#define UP ((bf16*)WSP(WS_U))
#define YP ((bf16*)WSP(WS_Y))
#define ZP ((bf16*)WSP(WS_Z))
#define GP ((bf16*)WSP(WS_G))
#define PROJP ((bf16*)WSP(WS_PROJ))

    if (IN(0)) { p0_prologue(F); if (BOTH(0)) GRID_BAR(); }

#pragma clang loop unroll(disable)
    for (int l = 0; l < DEPTH; ++l) {
        const int pb = 1 + l * NP;
        if (pb + NP <= lo || pb >= hi) continue;
        if (IN(pb + 0)) { norm_mod_phase(F, (l == 0) ? INP(I_X) : (const float*)HP, INP(I_GFFN1) + (size_t)l * D, MODP(l, 0), MODP(l, 1), UP); if (BOTH(pb + 0)) GRID_BAR(); }
        if (IN(pb + 1)) { pg8::Gemm g{UP, LW(l, LW_13A), M, 2 * FF, D}; pg8::StaticOrder S; S.init(M, 2 * FF, F.G, (int)blockIdx.x); pg8::EpiSwiGLU E{GP, FF};
            pg8::gemm_phase<pg8::EpiSwiGLU, pg8::StaticOrder, true, true>(F.lds + RING_OFF, g, S, E); if (BOTH(pb + 1)) GRID_BAR(); }
        if (IN(pb + 2)) { pg8::Gemm g{GP, LW(l, LW_2A), M, D, FF}; pg8::StaticOrder S; S.init(M, D, F.G, (int)blockIdx.x); pg8::EpiResid E{(l == 0) ? INP(I_X) : (const float*)HP, HP, D, MODP(l, 2), MODW, 0.5f};
            pg8::gemm_phase<pg8::EpiResid, pg8::StaticOrder, true, true>(F.lds + RING_OFF, g, S, E); if (BOTH(pb + 2)) GRID_BAR(); }
        if (IN(pb + 3)) { norm_mod_phase(F, HP, INP(I_GMIX) + (size_t)l * D, MODP(l, 3), MODP(l, 4), UP); if (BOTH(pb + 3)) GRID_BAR(); }
        if (IN(pb + 4)) { pg8::Gemm g{UP, LW(l, LW_IN), M, NINP, D}; pg8::StaticOrder S; S.init(M, NINP, F.G, (int)blockIdx.x); pg8::EpiPlain E{PROJP, NINP};
            pg8::gemm_phase<pg8::EpiPlain, pg8::StaticOrder, true, true>(F.lds + RING_OFF, g, S, E); if (BOTH(pb + 4)) GRID_BAR(); }
        if (IN(pb + 5)) { if (BOTH(pb + 5)) GRID_BAR(); }
        if (IN(pb + 6)) { if (BOTH(pb + 6)) GRID_BAR(); }
        if (IN(pb + 7)) { if (BOTH(pb + 7)) GRID_BAR(); }
        if (IN(pb + 8)) { pg8::Gemm g{ZP, LW(l, LW_GLU), M, S5_W, S5_W}; pg8::StaticOrder S; S.init(M, S5_W, F.G, (int)blockIdx.x); pg8::EpiGlu E{ZP, S5_W, YP, D, 1024, INP(I_BGLU) + (size_t)l * S5_W};
            pg8::gemm_phase<pg8::EpiGlu, pg8::StaticOrder, true, true>(F.lds + RING_OFF, g, S, E); if (BOTH(pb + 8)) GRID_BAR(); }
        if (IN(pb + 9)) { pg8::Gemm g{YP, LW(l, LW_OUT), M, D, D}; pg8::StaticOrder S; S.init(M, D, F.G, (int)blockIdx.x); pg8::EpiResid E{HP, HP, D, MODP(l, 5), MODW, 1.0f};
            pg8::gemm_phase<pg8::EpiResid, pg8::StaticOrder, true, true>(F.lds + RING_OFF, g, S, E); if (BOTH(pb + 9)) GRID_BAR(); }
        if (IN(pb + 10)) { norm_mod_phase(F, HP, INP(I_GFFN2) + (size_t)l * D, MODP(l, 6), MODP(l, 7), UP); if (BOTH(pb + 10)) GRID_BAR(); }
        if (IN(pb + 11)) { pg8::Gemm g{UP, LW(l, LW_13B), M, 2 * FF, D}; pg8::StaticOrder S; S.init(M, 2 * FF, F.G, (int)blockIdx.x); pg8::EpiSwiGLU E{GP, FF};
            pg8::gemm_phase<pg8::EpiSwiGLU, pg8::StaticOrder, true, true>(F.lds + RING_OFF, g, S, E); if (BOTH(pb + 11)) GRID_BAR(); }
        if (IN(pb + 12)) { pg8::Gemm g{GP, LW(l, LW_2B), M, D, FF}; pg8::StaticOrder S; S.init(M, D, F.G, (int)blockIdx.x); pg8::EpiResid E{HP, HP, D, MODP(l, 8), MODW, 0.5f};
            pg8::gemm_phase<pg8::EpiResid, pg8::StaticOrder, true, true>(F.lds + RING_OFF, g, S, E); if (BOTH(pb + 12)) GRID_BAR(); }
    }
    if (IN(PH_FINAL)) final_norm_phase(F, HP, INP(I_GFINAL), kargs()->out);
#undef IN
#undef BOTH
#undef GRID_BAR
}

__global__ void __launch_bounds__(512) naive_la(const bf16* proj, const float* wg, const float* bg, float* la) {
    const int m = blockIdx.x, dir = threadIdx.x >> 8, c = threadIdx.x & 255;
    float s = bg[dir * 256 + c];
#pragma unroll
    for (int r = 0; r < GLA_R; ++r) s += bf2f(proj[(size_t)m * NINP + PC_LR + dir * 16 + r]) * wg[(dir * 16 + r) * 256 + c];
    la[((size_t)m * 2 + dir) * 256 + c] = (fminf(s, 0.f) - log1pf(expf(-fabsf(s)))) * (1.0f / 16.0f);
}
template <int DK, int DV, int MODE>
__global__ void __launch_bounds__(256) naive_linrec(const bf16* proj, const float* la, float* o, int dir) {
    constexpr int ES = 32, NE = DV / ES, DPT = DK / 8, TB = 16, NH = 4, OW = NH * DV;
    const int bid = blockIdx.x, es = bid % NE, h = (bid / NE) % NH, b = bid / (NE * NH);
    const int tid = threadIdx.x, e = tid & 31, dg = tid >> 5;
    __shared__ float q_s[TB][DK], k_s[TB][DK], a_s[TB][DK], v_s[TB][ES], red[TB][8][ES];
    constexpr int qoff = MODE == 0 ? PC_RQ : PC_GQ, koff = MODE == 0 ? PC_RK : PC_GK, voff = MODE == 0 ? PC_RV : PC_GV;
    const float gamma = 1.0f - exp2f(-5.0f - (float)h);
    const float scale = MODE == 0 ? 0.08838834764831845f : 0.125f;
    float S[DPT];
#pragma unroll
    for (int i = 0; i < DPT; ++i) S[i] = 0.f;
    for (int bi = 0; bi < SEQ / TB; ++bi) {
        const int t0 = dir == 0 ? bi * TB : SEQ - TB - bi * TB;
        if (MODE == 0) {
            for (int idx = tid; idx < TB * 64; idx += 256) { const int s = idx >> 6, j = idx & 63, t = t0 + s; const size_t row = (size_t)(b * SEQ + t) * NINP;
                const float ang = (float)t * powf(10000.0f, -(float)(2 * j) / 128.0f); const float sn = sinf(ang), cs = cosf(ang);
                const float q1 = bf2f(proj[row + qoff + h * DK + j]), q2 = bf2f(proj[row + qoff + h * DK + 64 + j]);
                const float k1 = bf2f(proj[row + koff + h * DK + j]), k2 = bf2f(proj[row + koff + h * DK + 64 + j]);
                q_s[s][j] = (q1 * cs - q2 * sn) * scale; q_s[s][64 + j] = (q1 * sn + q2 * cs) * scale;
                k_s[s][j] = k1 * cs - k2 * sn; k_s[s][64 + j] = k1 * sn + k2 * cs; }
        } else {
            for (int idx = tid; idx < TB * DK; idx += 256) { const int s = idx / DK, d = idx % DK, t = t0 + s; const size_t row = (size_t)(b * SEQ + t);
                q_s[s][d] = bf2f(proj[row * NINP + qoff + h * DK + d]) * scale; k_s[s][d] = bf2f(proj[row * NINP + koff + h * DK + d]);
                a_s[s][d] = expf(la[(row * 2 + dir) * 256 + h * DK + d]); }
        }
        for (int idx = tid; idx < TB * ES; idx += 256) { const int s = idx >> 5, ee = idx & 31; v_s[s][ee] = bf2f(proj[(size_t)(b * SEQ + t0 + s) * NINP + voff + h * DV + es * ES + ee]); }
        __syncthreads();
        for (int ss = 0; ss < TB; ++ss) { const int s = dir == 0 ? ss : TB - 1 - ss;
            const float v = v_s[s][e]; float acc = 0.f;
#pragma unroll
            for (int i = 0; i < DPT; ++i) { const int d = dg * DPT + i; const float a = MODE == 0 ? gamma : a_s[s][d];
                const float dec = a * S[i], sn = dec + k_s[s][d] * v; acc += q_s[s][d] * (dir == 0 ? sn : dec); S[i] = sn; }
            red[s][dg][e] = acc; }
        __syncthreads();
        for (int idx = tid; idx < TB * ES; idx += 256) { const int s = idx >> 5, ee = idx & 31; float sum = 0.f;
#pragma unroll
            for (int w = 0; w < 8; ++w) sum += red[s][w][ee];
            float* op = o + (size_t)(b * SEQ + t0 + s) * OW + h * DV + es * ES + ee; if (dir == 0) *op = sum; else *op += sum; }
    }
}
__device__ __forceinline__ float gelu_tanh(float x) { const float u = 0.7978845608028654f * (x + 0.044715f * x * x * x); return 0.5f * x * (1.0f + tanhf(u)); }
__global__ void __launch_bounds__(64) naive_s5(const bf16* proj, const float* lamb, const float* bbar, const float* cre, const float* cim, const float* dsk, float* ys5, bf16* Z) {
    const int g = blockIdx.x % S5_G, b = blockIdx.x / S5_G, p = threadIdx.x;
    __shared__ float u_s[64][16]; __shared__ float part[16][65];
    for (int dir = 0; dir < 2; ++dir) {
        const int gi = (dir * S5_G + g) * S5_P + p;
        const float lr = lamb[2 * gi], li = lamb[2 * gi + 1];
        float Br[16], Bi[16], Cr[16], Ci[16];
#pragma unroll
        for (int c = 0; c < 16; ++c) { Br[c] = bbar[((size_t)gi * 16 + c) * 2]; Bi[c] = bbar[((size_t)gi * 16 + c) * 2 + 1];
            Cr[c] = cre[((size_t)(dir * S5_G + g) * 16 + c) * S5_P + p]; Ci[c] = cim[((size_t)(dir * S5_G + g) * 16 + c) * S5_P + p]; }
        float xr = 0.f, xi = 0.f;
        for (int bi = 0; bi < SEQ / 64; ++bi) {
            const int t0 = dir == 0 ? bi * 64 : SEQ - 64 - bi * 64;
            { const size_t row = (size_t)(b * SEQ + t0 + p) * NINP + PC_SU + g * 16;
#pragma unroll
              for (int c = 0; c < 16; ++c) u_s[p][c] = bf2f(proj[row + c]); }
            __syncthreads();
            for (int ss = 0; ss < 64; ++ss) { const int s = dir == 0 ? ss : 63 - ss;
                float bur = 0.f, bui = 0.f;
#pragma unroll
                for (int c = 0; c < 16; ++c) { const float uv = u_s[s][c]; bur += Br[c] * uv; bui += Bi[c] * uv; }
                const float nr = lr * xr - li * xi + bur, ni = lr * xi + li * xr + bui; xr = nr; xi = ni;
#pragma unroll
                for (int c = 0; c < 16; ++c) part[c][p] = Cr[c] * xr - Ci[c] * xi;
                __syncthreads();
                const int c = p >> 2, q = p & 3; float sm = 0.f;
#pragma unroll
                for (int i = 0; i < 16; ++i) sm += part[c][q * 16 + i];
                sm += __shfl_xor(sm, 1); sm += __shfl_xor(sm, 2);
                if (q == 0) { const size_t idx = (size_t)(b * SEQ + t0 + s) * S5_W + g * 16 + c;
                    if (dir == 0) ys5[idx] = dsk[g * 16 + c] * u_s[s][c] + sm;
                    else { const float y = ys5[idx] + sm; ys5[idx] = y; Z[idx] = (bf16)f2bf(gelu_tanh(y)); } }
                __syncthreads();
            }
        }
    }
}
__global__ void __launch_bounds__(256) naive_post(const bf16* proj, const float* oret, const float* ogla, bf16* Y) {
    const int m = blockIdx.x * 4 + (threadIdx.x >> 6), lane = threadIdx.x & 63;
    for (int h = 0; h < 4; ++h) {
        float v[4]; float s = 0.f;
#pragma unroll
        for (int j = 0; j < 4; ++j) { v[j] = oret[(size_t)m * 1024 + h * 256 + j * 64 + lane]; s += v[j]; }
        const float mu = wave_sum(s) * (1.0f / 256.0f); float q = 0.f;
#pragma unroll
        for (int j = 0; j < 4; ++j) { v[j] -= mu; q += v[j] * v[j]; }
        const float rstd = 1.0f / sqrtf(wave_sum(q) * (1.0f / 256.0f) + EPS);
#pragma unroll
        for (int j = 0; j < 4; ++j) { const int c = h * 256 + j * 64 + lane; const float gt = bf2f(proj[(size_t)m * NINP + PC_RG + c]); Y[(size_t)m * D + c] = (bf16)f2bf(gt / (1.0f + expf(-gt)) * v[j] * rstd); }
    }
    for (int h = 0; h < 4; ++h) {
        float v[2]; float q = 0.f;
#pragma unroll
        for (int j = 0; j < 2; ++j) { v[j] = ogla[(size_t)m * 512 + h * 128 + j * 64 + lane]; q += v[j] * v[j]; }
        const float rstd = 1.0f / sqrtf(wave_sum(q) * (1.0f / 128.0f) + EPS);
#pragma unroll
        for (int j = 0; j < 2; ++j) { const int c = h * 128 + j * 64 + lane; const float gt = bf2f(proj[(size_t)m * NINP + PC_GR + c]); Y[(size_t)m * D + 1536 + c] = (bf16)f2bf(gt / (1.0f + expf(-gt)) * v[j] * rstd); }
    }
}

static void launch_mega(const Args& base, int lo, int hi, int& li, int grid, hipStream_t stream) {
    Args a = base; a.ph_lo = lo; a.ph_hi = hi; a.li = li++;
    hipLaunchKernelGGL(mega, dim3(grid), dim3(NWAVES * 64), LDS_BYTES, stream, a);
}
extern "C" void kernel_launch(void* const* d_in, const int* in_sizes, int n_in, void* d_out, int out_size, void* d_ws, size_t ws_size, hipStream_t stream) {
    static int grid = 0;
    if (grid == 0) {
        if (n_in != 28 || in_sizes[0] != M * D || out_size != M * D || ws_size < WS_END) { fprintf(stderr, "kernel_launch: unexpected shapes: n_in %d in0 %d out %d ws %zu (need %zu)\n", n_in, n_in > 0 ? in_sizes[0] : -1, out_size, ws_size, (size_t)WS_END); grid = -1; return; }
        int dev = 0, cus = 0, per_cu = 0;
        if (hipGetDevice(&dev) != hipSuccess || hipDeviceGetAttribute(&cus, hipDeviceAttributeMultiprocessorCount, dev) != hipSuccess) { grid = -1; return; }
        if (hipFuncSetAttribute((const void*)mega, hipFuncAttributeMaxDynamicSharedMemorySize, LDS_BYTES) != hipSuccess) { fprintf(stderr, "kernel_launch: hipFuncSetAttribute failed\n"); grid = -1; return; }
        if (hipOccupancyMaxActiveBlocksPerMultiprocessor(&per_cu, (const void*)mega, NWAVES * 64, LDS_BYTES) != hipSuccess || per_cu < 1) fprintf(stderr, "kernel_launch: occupancy query reports %d\n", per_cu);
        (void)hipGetLastError();
        grid = cus;
    }
    if (grid < 0) return;
    hipMemsetAsync((char*)d_ws + WS_CTL, 0, CTL_ZERO_BYTES, stream);
    Args a{};
    for (int i = 0; i < 28; ++i) a.in[i] = (const float*)d_in[i];
    a.out = (float*)d_out; a.ws = (unsigned char*)d_ws;
    unsigned char* ws = (unsigned char*)d_ws;
    int li = 0;
#if MK_MODE == 0
    launch_mega(a, 0, 1, li, grid, stream);
    for (int l = 0; l < DEPTH; ++l) {
        const int pb = 1 + l * NP;
        for (int k = 0; k <= 4; ++k) launch_mega(a, pb + k, pb + k + 1, li, grid, stream);
        const bf16* proj = (const bf16*)(ws + WS_PROJ); float* la = (float*)(ws + WS_LA); float* oret = (float*)(ws + WS_ORET); float* ogla = (float*)(ws + WS_OGLA); float* ys5 = (float*)(ws + WS_YS5);
        hipLaunchKernelGGL(naive_la, dim3(M), dim3(512), 0, stream, proj, a.in[I_WGATE] + (size_t)l * 2 * 16 * 256, a.in[I_BGATE] + (size_t)l * 2 * 256, la);
        for (int dir = 0; dir < 2; ++dir) {
            hipLaunchKernelGGL((naive_linrec<128, 256, 0>), dim3(BATCH * 4 * 8), dim3(256), 0, stream, proj, (const float*)la, oret, dir);
            hipLaunchKernelGGL((naive_linrec<64, 128, 1>), dim3(BATCH * 4 * 4), dim3(256), 0, stream, proj, (const float*)la, ogla, dir);
        }
        hipLaunchKernelGGL(naive_s5, dim3(BATCH * S5_G), dim3(64), 0, stream, proj, (const float*)(ws + WS_S5L) + (size_t)l * 2 * 32 * 64 * 2, (const float*)(ws + WS_S5B) + (size_t)l * 2 * 32 * 64 * 16 * 2,
                           a.in[I_CRE] + (size_t)l * 2 * 32 * 16 * 64, a.in[I_CIM] + (size_t)l * 2 * 32 * 16 * 64, a.in[I_S5D] + (size_t)l * S5_W, ys5, (bf16*)(ws + WS_Z));
        hipLaunchKernelGGL(naive_post, dim3(M / 4), dim3(256), 0, stream, proj, (const float*)oret, (const float*)ogla, (bf16*)(ws + WS_Y));
        for (int k = 8; k <= 12; ++k) launch_mega(a, pb + k, pb + k + 1, li, grid, stream);
    }
    launch_mega(a, PH_FINAL, PH_END, li, grid, stream);
#else
    launch_mega(a, 0, PH_END, li, grid, stream);
#endif
}
```

```cpp
#ifndef MK_MODE
#define MK_MODE 1
#endif
#ifndef FAST_MASK
#define FAST_MASK 3
#endif
#ifndef PROBE_DUP
#define PROBE_DUP 0
#define STAGGER_TICKS 0
#define STAGGER_XCD 1
#define LOCAL_BARS 1
#define TEAM_SPLIT 0
#endif
#include <hip/hip_runtime.h>
#include <cstdio>
#include <cstdint>
__device__ __forceinline__ int lane_now() { int l; asm volatile("v_mbcnt_lo_u32_b32 %0, -1, 0\n\tv_mbcnt_hi_u32_b32 %0, -1, %0" : "=v"(l)); return l; }
typedef _Float16 h16; typedef _Float16 h16x4 __attribute__((ext_vector_type(4)));
namespace pg8 {
#define PG8_LAS __attribute__((address_space(3)))
typedef unsigned short bf16_t;
typedef short bf16x8 __attribute__((ext_vector_type(8)));
typedef float f32x4 __attribute__((ext_vector_type(4)));
typedef unsigned u32x4 __attribute__((ext_vector_type(4)));
constexpr int BM = 256, BK = 64, HALF = 128, HTB = HALF * BK * 2  , STAGE_BYTES = 8 * HTB, NXCD = 8, WGM = 8;

__host__ __device__ __forceinline__ int lds_byte(int r, int c) { const int st = (r >> 4) * 2 + (c >> 5), rr = r & 15, cc = c & 31, ob = rr * 64 + cc * 2; return st * 1024 + (ob ^ (((ob >> 9) & 1) << 5)); }
__host__ __device__ __forceinline__ void stage_rc(int b, int& R, int& C) { const int st = b / 1024, sb = b % 1024, swz = sb ^ (((sb >> 9) & 1) << 5); R = (st >> 1) * 16 + swz / 64; C = (st & 1) * 32 + (swz % 64) / 2; }
__host__ __device__ __forceinline__ int perm32(int rho) { const int n = rho >> 4, i = rho & 15; return 8 * (i >> 2) + 4 * n + (i & 3); }

struct Unit { int pm, pn, g; };
struct Gemm { const bf16_t* A; const bf16_t* Bt; int M, N, K; int lda, ldb; size_t sA, sB;
    __device__ __forceinline__ size_t a_off(const Unit& u) const { return ((size_t)u.g * sA + (size_t)u.pm * BM * lda) * 2; }
    __device__ __forceinline__ size_t b_off(const Unit& u) const { return ((size_t)u.g * sB + (size_t)u.pn * BM * ldb) * 2; } };
__device__ __forceinline__ Gemm mk_gemm(const bf16_t* A, const bf16_t* Bt, int M, int N, int K) { Gemm g; g.A = A; g.Bt = Bt; g.M = M; g.N = N; g.K = K; g.lda = K; g.ldb = K; g.sA = 0; g.sB = 0; return g; }

struct StaticOrder {
    int nM, nN, nwg, G, c, alt, pm0;
    __host__ __device__ void init(int M, int N, int G_, int c_) { nM = M / BM; nN = N / BM; nwg = nM * nN; G = G_; c = c_; alt = 0; pm0 = 0; }
    __host__ __device__ bool next(int i, Unit& u) const {
        const long L = (long)i * G + c; if (L >= nwg) return false;
        int wgid = (int)L; { const int q = nwg / NXCD, r = nwg % NXCD, xcd = wgid % NXCD, off = wgid / NXCD; wgid = (xcd < r ? xcd * (q + 1) : r * (q + 1) + (xcd - r) * q) + off; }
        const int nig = WGM * nN, gid = wgid / nig, fm = gid * WGM, gsz = (nM - fm) < WGM ? (nM - fm) : WGM;
        if (alt) { const int w = wgid % nig, idx = w & 31; u.pm = fm + 4 * (w >> 5) + (idx & 3); u.pn = idx >> 2; }
        else { u.pm = fm + ((wgid % nig) % gsz); u.pn = (wgid % nig) / gsz; }
        u.pm += pm0; u.g = 0; return true;
    }
    __device__ __forceinline__ void a_ready(const Unit&) const {}
    __device__ __forceinline__ void done(const Unit&) const {}
};
struct BatchOrder {
    int nM, nN, nb, G, c, pm0;
    __device__ __forceinline__ void init(int M, int N, int nb_, int G_, int c_) { nM = M / BM; nN = N / BM; nb = nb_; G = G_; c = c_; pm0 = 0; }
    __device__ __forceinline__ bool next(int i, Unit& u) const { const int L = i * G + c; if (L >= nb * nM * nN) return false; u.pn = L % nN; const int r = L / nN; u.pm = r % nM + pm0; u.g = r / nM; return true; }
    __device__ __forceinline__ void a_ready(const Unit&) const {}
    __device__ __forceinline__ void done(const Unit&) const {}
};

__device__ __forceinline__ unsigned cvt_pk_bf16(float lo, float hi) { unsigned r; asm volatile("v_cvt_pk_bf16_f32 %0, %1, %2" : "=v"(r) : "v"(lo), "v"(hi)); return r; }
typedef float f32x2 __attribute__((ext_vector_type(2)));
__device__ __forceinline__ float fast_sigmoid(float a) { return __builtin_amdgcn_rcpf(1.0f + __expf(-a)); }
struct EpiProj {
    static constexpr bool PERM = true, AFTER_DRAIN = false;
    bf16_t* O; int ldc; const float* rcos; const float* rsin; bf16_t* sua;
    __device__ __forceinline__ void operator()(const f32x4 (&acc)[2][2][4][2], const Unit& u, int wr, int wc, int fr, int fq) const {
        const int row0 = u.pm * BM + wr * 64 + fr;
        if (u.pn < 4) {
            const int c128 = wc * 32 + 8 * fq, hl = c128 >> 6, dl0 = c128 & 63; const float sc = (u.pn < 2) ? 0.08838834764831845f : 1.0f;
            const int colb = (u.pn < 2 ? 0 : 512) + ((u.pn & 1) * 2 + hl) * 128 + dl0;
#pragma unroll
            for (int ai = 0; ai < 2; ++ai) {
                f32x4 tc0[4], tc1[4], ts0[4], ts1[4];
#pragma unroll
                for (int m = 0; m < 4; ++m) { const int pos = (row0 + ai * HALF + m * 16) & 4095;
                    tc0[m] = *(const f32x4*)(rcos + pos * 64 + dl0); tc1[m] = *(const f32x4*)(rcos + pos * 64 + dl0 + 4); ts0[m] = *(const f32x4*)(rsin + pos * 64 + dl0); ts1[m] = *(const f32x4*)(rsin + pos * 64 + dl0 + 4); }
#pragma unroll
                for (int m = 0; m < 4; ++m) { const int row = row0 + ai * HALF + m * 16;
                    const f32x4 c0 = tc0[m], c1 = tc1[m], s0 = ts0[m], s1 = ts1[m];
                    const f32x4 a0 = acc[ai][0][m][0] * sc, a1 = acc[ai][0][m][1] * sc, b0 = acc[ai][1][m][0] * sc, b1 = acc[ai][1][m][1] * sc;
                    const f32x4 x0 = a0 * c0 - b0 * s0, x1 = a1 * c1 - b1 * s1, y0 = a0 * s0 + b0 * c0, y1 = a1 * s1 + b1 * c1;
                    u32x4 w; w.x = cvt_pk_bf16(x0[0], x0[1]); w.y = cvt_pk_bf16(x0[2], x0[3]); w.z = cvt_pk_bf16(x1[0], x1[1]); w.w = cvt_pk_bf16(x1[2], x1[3]);
                    u32x4 v; v.x = cvt_pk_bf16(y0[0], y0[1]); v.y = cvt_pk_bf16(y0[2], y0[3]); v.z = cvt_pk_bf16(y1[0], y1[1]); v.w = cvt_pk_bf16(y1[2], y1[3]);
                    bf16_t* rowp = O + (size_t)row * ldc + colb; *(u32x4*)rowp = w; *(u32x4*)(rowp + 64) = v; }
                asm volatile("" ::: "memory"); }
            return;
        }
        const int col0 = u.pn * BM + wc * 32 + 8 * fq; const float sc = (u.pn == 14) ? 0.125f : 1.0f; const bool is_su = (u.pn == 12 || u.pn == 13);
#pragma unroll
        for (int ai = 0; ai < 2; ++ai)
#pragma unroll
            for (int m = 0; m < 4; ++m) { const int row = row0 + ai * HALF + m * 16; bf16_t* rowp = O + (size_t)row * ldc + col0;
#pragma unroll
                for (int bj = 0; bj < 2; ++bj) { const f32x4 v0 = acc[ai][bj][m][0] * sc, v1 = acc[ai][bj][m][1] * sc;
                    u32x4 w; w.x = cvt_pk_bf16(v0[0], v0[1]); w.y = cvt_pk_bf16(v0[2], v0[3]); w.z = cvt_pk_bf16(v1[0], v1[1]); w.w = cvt_pk_bf16(v1[2], v1[3]);
                    *(u32x4*)(rowp + bj * HALF) = w;
                    if (is_su) { const int ch = col0 + bj * HALF - 3072; *(u32x4*)(sua + ((size_t)(ch >> 4) * 512 + (row >> 5)) * 768 + (row & 31) * 16 + (ch & 15)) = w; } } }
    }
};
struct EpiS5State {
    static constexpr bool PERM = false, AFTER_DRAIN = false;
    float* SC;
    __device__ __forceinline__ void operator()(const f32x4 (&acc)[2][2][4][2], const Unit& u, int wr, int wc, int fr, int fq) const {
        const int row0 = u.pm * BM + wr * 64 + fr, col0 = wc * 32 + 4 * fq;
#pragma unroll
        for (int ai = 0; ai < 2; ++ai)
#pragma unroll
            for (int m = 0; m < 4; ++m) { float* rowp = SC + ((size_t)u.g * 512 + row0 + ai * HALF + m * 16) * 256 + col0;
#pragma unroll
                for (int bj = 0; bj < 2; ++bj)
#pragma unroll
                    for (int n = 0; n < 2; ++n) *(f32x4*)(rowp + bj * HALF + n * 16) = acc[ai][bj][m][n]; }
    }
};
__device__ __forceinline__ float gelu_tanh_f(float x) { const float u = 0.7978845608028654f * (x + 0.044715f * x * x * x); const float e = __expf(2.0f * u); return x - x * __builtin_amdgcn_rcpf(e + 1.0f); }
struct EpiS5Out {
    static constexpr bool PERM = true, AFTER_DRAIN = false;
    bf16_t* Z;
    __device__ __forceinline__ void operator()(const f32x4 (&acc)[2][2][4][2], const Unit& u, int wr, int wc, int fr, int fq) const {
        const int row0 = u.pm * BM + wr * 64 + fr, col0 = u.pn * BM + wc * 32 + 8 * fq;
#pragma unroll
        for (int ai = 0; ai < 2; ++ai)
#pragma unroll
            for (int m = 0; m < 4; ++m) { const int chunk = row0 + ai * HALF + m * 16;
#pragma unroll
                for (int bj = 0; bj < 2; ++bj) { const int col = col0 + bj * HALF, t = col >> 4, cp = col & 15; const f32x4 v0 = acc[ai][bj][m][0], v1 = acc[ai][bj][m][1];
                    u32x4 w; w.x = cvt_pk_bf16(gelu_tanh_f(v0[0]), gelu_tanh_f(v0[1])); w.y = cvt_pk_bf16(gelu_tanh_f(v0[2]), gelu_tanh_f(v0[3])); w.z = cvt_pk_bf16(gelu_tanh_f(v1[0]), gelu_tanh_f(v1[1])); w.w = cvt_pk_bf16(gelu_tanh_f(v1[2]), gelu_tanh_f(v1[3]));
                    *(u32x4*)(Z + ((size_t)chunk * 32 + t) * 512 + u.g * 16 + cp) = w; } }
    }
};
struct EpiSwiGLU {
    static constexpr bool PERM = true, AFTER_DRAIN = false;
    bf16_t* O; int ldc;
    __device__ __forceinline__ void operator()(const f32x4 (&acc)[2][2][4][2], const Unit& u, int wr, int wc, int fr, int fq) const {
        const int row0 = u.pm * BM + wr * 64 + fr, col0 = u.pn * HALF + wc * 32 + 8 * fq;
#pragma unroll
        for (int ai = 0; ai < 2; ++ai)
#pragma unroll
            for (int m = 0; m < 4; ++m) { bf16_t* rowp = O + (size_t)(row0 + ai * HALF + m * 16) * ldc + col0;
                float r[8];
#pragma unroll
                for (int n = 0; n < 2; ++n)
#pragma unroll
                    for (int j = 0; j < 4; j += 2) {
                        const f32x2 a = (f32x2){acc[ai][0][m][n][j], acc[ai][0][m][n][j + 1]}, b = (f32x2){acc[ai][1][m][n][j], acc[ai][1][m][n][j + 1]};
                        const f32x2 t = a * -1.4426950408889634f; const f32x2 e = (f32x2){__builtin_amdgcn_exp2f(t.x), __builtin_amdgcn_exp2f(t.y)} + 1.0f;
                        const f32x2 o = (a * b) * (f32x2){__builtin_amdgcn_rcpf(e.x), __builtin_amdgcn_rcpf(e.y)}; r[n * 4 + j] = o.x; r[n * 4 + j + 1] = o.y; }
                u32x4 w; w.x = cvt_pk_bf16(r[0], r[1]); w.y = cvt_pk_bf16(r[2], r[3]); w.z = cvt_pk_bf16(r[4], r[5]); w.w = cvt_pk_bf16(r[6], r[7]);
                *(u32x4*)rowp = w; }
    }
};
struct EpiResid {
    static constexpr bool PERM = true, AFTER_DRAIN = false;
    const h16* base; h16* out; int ldc; const float* gate; int gstride; float coef;
    __device__ __forceinline__ void operator()(const f32x4 (&acc)[2][2][4][2], const Unit& u, int wr, int wc, int fr, int fq) const {
        typedef _Float16 h16x8 __attribute__((ext_vector_type(8)));
        const int row0 = u.pm * BM + wr * 64 + fr, col0 = u.pn * BM + wc * 32 + 8 * fq;
        const float* gp = gate + (size_t)(u.pm >> 4) * gstride + col0;
        f32x4 gv[2][2];
#pragma unroll
        for (int bj = 0; bj < 2; ++bj)
#pragma unroll
            for (int n = 0; n < 2; ++n) gv[bj][n] = *(const f32x4*)(gp + bj * HALF + n * 4) * coef;
#pragma unroll
        for (int ai = 0; ai < 2; ++ai) {
            h16x8 bs[4][2];
#pragma unroll
            for (int m = 0; m < 4; ++m) { const size_t off = (size_t)(row0 + ai * HALF + m * 16) * ldc + col0;
#pragma unroll
                for (int bj = 0; bj < 2; ++bj) bs[m][bj] = *(const h16x8*)(base + off + bj * HALF); }
#pragma unroll
            for (int m = 0; m < 4; ++m) { const size_t off = (size_t)(row0 + ai * HALF + m * 16) * ldc + col0;
#pragma unroll
                for (int bj = 0; bj < 2; ++bj) { const h16x8 b8 = bs[m][bj];
                    const f32x4 lo = __builtin_convertvector(__builtin_shufflevector(b8, b8, 0, 1, 2, 3), f32x4) + gv[bj][0] * acc[ai][bj][m][0];
                    const f32x4 hi = __builtin_convertvector(__builtin_shufflevector(b8, b8, 4, 5, 6, 7), f32x4) + gv[bj][1] * acc[ai][bj][m][1];
                    const h16x4 l4 = __builtin_convertvector(lo, h16x4), h4 = __builtin_convertvector(hi, h16x4);
                    *(h16x8*)(out + off + bj * HALF) = __builtin_shufflevector(l4, h4, 0, 1, 2, 3, 4, 5, 6, 7); } }
            asm volatile("" ::: "memory"); }
    }
};
struct EpiGlu {
    static constexpr bool PERM = true, AFTER_DRAIN = false;
    const bf16_t* Z; int ldz; bf16_t* Y; int ldy; int ycol0; const float* bias;
    __device__ __forceinline__ void operator()(const f32x4 (&acc)[2][2][4][2], const Unit& u, int wr, int wc, int fr, int fq) const {
        const int row0 = u.pm * BM + wr * 64 + fr, col0 = u.pn * BM + wc * 32 + 8 * fq;
        f32x4 bv[2][2];
#pragma unroll
        for (int bj = 0; bj < 2; ++bj)
#pragma unroll
            for (int n = 0; n < 2; ++n) bv[bj][n] = *(const f32x4*)(bias + col0 + bj * HALF + 4 * n);
#pragma unroll
        for (int ai = 0; ai < 2; ++ai)
#pragma unroll
            for (int m = 0; m < 4; ++m) { const size_t r = (size_t)(row0 + ai * HALF + m * 16);
#pragma unroll
                for (int bj = 0; bj < 2; ++bj) { const u32x4 zz = *(const u32x4*)(Z + r * ldz + col0 + bj * HALF);
                    const f32x4 v0 = acc[ai][bj][m][0] + bv[bj][0], v1 = acc[ai][bj][m][1] + bv[bj][1];
                    float o[8];
#pragma unroll
                    for (int j = 0; j < 4; ++j) { const unsigned zw = zz[j]; const float zl = __uint_as_float(zw << 16), zh = __uint_as_float(zw & 0xffff0000u);
                        const float g0 = (j < 2) ? v0[2 * j] : v1[2 * j - 4], g1 = (j < 2) ? v0[2 * j + 1] : v1[2 * j - 3];
                        o[2 * j] = zl * fast_sigmoid(g0); o[2 * j + 1] = zh * fast_sigmoid(g1); }
                    u32x4 w; w.x = cvt_pk_bf16(o[0], o[1]); w.y = cvt_pk_bf16(o[2], o[3]); w.z = cvt_pk_bf16(o[4], o[5]); w.w = cvt_pk_bf16(o[6], o[7]);
                    *(u32x4*)(Y + r * ldy + ycol0 + col0 + bj * HALF) = w; }
                asm volatile("" ::: "memory"); }
    }
};
template <class Epi, class Sched, bool ALIGN_EPI = false, bool SP2 = false>
__device__ __forceinline__ void gemm_phase(PG8_LAS unsigned char* lds, const Gemm g, const Sched& S, const Epi& E, const int wave_id) {
    const int lane = lane_now(), wid = wave_id, tid = wid * 64 + lane, wr = wid >> 2, wc = wid & 3, fr = lane & 15, fq = lane >> 4;
    const int K = g.K, nt = K / BK;
    unsigned voffA[2], voffB[2];
#pragma unroll
    for (int i = 0; i < 2; ++i) { int R, C; stage_rc(tid * 16 + i * 8192, R, C); const int Rb = Epi::PERM ? ((R & ~31) + perm32(R & 31)) : R;
        voffA[i] = (unsigned)(R * g.lda + C) * 2u; voffB[i] = (unsigned)(Rb * g.ldb + C) * 2u; }
    const size_t kstep = (size_t)(BK * 2);
    const size_t hstepA = (size_t)HALF * g.lda * 2, hstepB = (size_t)HALF * g.ldb * 2;
    const unsigned ldsw = (unsigned)wid * 1024u;
    const int aoff = lds_byte(wr * 64 + fr, fq * 8), boff = lds_byte(wc * 32 + fr, fq * 8);
#define PG8_SA(b, h) (((b) * 2 + (h)) * HTB)
#define PG8_SB(b, h) ((4 + (b) * 2 + (h)) * HTB)
#define PG8_STAGE(bufoff, gbase, voff) do { _Pragma("unroll") for (int _i = 0; _i < 2; ++_i) \
        __builtin_amdgcn_global_load_lds((const unsigned*)((const char*)(gbase) + (voff)[_i]), (PG8_LAS unsigned*)(lds + (bufoff) + ldsw + _i * 8192), 16, 0, 0); } while (0)
#define PG8_LDA(dst, b, h) do { _Pragma("unroll") for (int m = 0; m < 4; ++m) _Pragma("unroll") for (int k = 0; k < 2; ++k) dst[m][k] = *(const PG8_LAS bf16x8*)(lds + PG8_SA(b, h) + aoff + m * 2048 + k * 1024); } while (0)
#define PG8_LDB(dst, b, h) do { _Pragma("unroll") for (int n = 0; n < 2; ++n) _Pragma("unroll") for (int k = 0; k < 2; ++k) dst[n][k] = *(const PG8_LAS bf16x8*)(lds + PG8_SB(b, h) + boff + n * 2048 + k * 1024); } while (0)
#define PG8_MMA(ai, bj, At, Bt) do { __builtin_amdgcn_s_setprio(1); _Pragma("unroll") for (int m = 0; m < 4; ++m) _Pragma("unroll") for (int n = 0; n < 2; ++n) _Pragma("unroll") for (int k = 0; k < 2; ++k) \
        acc[ai][bj][m][n] = __builtin_amdgcn_mfma_f32_16x16x32_bf16(Bt[n][k], At[m][k], acc[ai][bj][m][n], 0, 0, 0); __builtin_amdgcn_s_setprio(0); } while (0)
#define PG8_WAIT_V(n) asm volatile("s_waitcnt vmcnt(" #n ")" ::: "memory")
#define PG8_WAIT_L(n) asm volatile("s_waitcnt lgkmcnt(" #n ")" ::: "memory")
#define PG8_BAR __builtin_amdgcn_s_barrier()
#define PG8_SCHED __builtin_amdgcn_sched_barrier(0)
    Unit cur, nxt; int ui = 0;
    if (!S.next(0, cur)) return;
    f32x4 acc[2][2][4][2];
#pragma unroll
    for (int a = 0; a < 2; ++a)
#pragma unroll
        for (int b = 0; b < 2; ++b)
#pragma unroll
            for (int m = 0; m < 4; ++m)
#pragma unroll
                for (int n = 0; n < 2; ++n) acc[a][b][m][n] = (f32x4){0.f, 0.f, 0.f, 0.f};
    bf16x8 At[4][2], B0[2][2], B1[2][2];
    const char* cA = (const char*)g.A + g.a_off(cur); const char* cB = (const char*)g.Bt + g.b_off(cur);
    S.a_ready(cur);
    if constexpr (SP2) {
        PG8_STAGE(PG8_SB(0, 0), cB, voffB); PG8_STAGE(PG8_SB(0, 1), cB + hstepB, voffB); PG8_STAGE(PG8_SA(0, 0), cA, voffA); PG8_STAGE(PG8_SA(0, 1), cA + hstepA, voffA);
        if (wr == 1) PG8_BAR;
        PG8_WAIT_V(2); PG8_BAR;
        PG8_STAGE(PG8_SB(1, 0), cB + kstep, voffB); PG8_STAGE(PG8_SA(1, 0), cA + kstep, voffA); PG8_STAGE(PG8_SB(1, 1), cB + hstepB + kstep, voffB);
        PG8_WAIT_V(6); PG8_BAR;
    } else {
        PG8_STAGE(PG8_SB(0, 0), cB, voffB); PG8_STAGE(PG8_SA(0, 0), cA, voffA); PG8_STAGE(PG8_SB(0, 1), cB + hstepB, voffB); PG8_STAGE(PG8_SA(0, 1), cA + hstepA, voffA);
        if (wr == 1) PG8_BAR;
        PG8_WAIT_V(4); PG8_BAR;
        PG8_STAGE(PG8_SB(1, 0), cB + kstep, voffB); PG8_STAGE(PG8_SA(1, 0), cA + kstep, voffA); PG8_STAGE(PG8_SB(1, 1), cB + hstepB + kstep, voffB);
        PG8_WAIT_V(6); PG8_BAR;
    }
    for (;;) {
        const bool has_next = S.next(ui + 1, nxt);
        const char* nA = has_next ? (const char*)g.A + g.a_off(nxt) : cA; const char* nB = has_next ? (const char*)g.Bt + g.b_off(nxt) : cB;
        for (int t = 0; t < nt; t += 2) {
            const bool last = (t == nt - 2);
            const char* a1 = cA + (size_t)(t + 1) * kstep;
            const char* a2 = last ? nA : cA + (size_t)(t + 2) * kstep; const char* b2 = last ? nB : cB + (size_t)(t + 2) * kstep;
            const char* a3 = a2 + kstep; const char* b3 = b2 + kstep;
            if (last && has_next) S.a_ready(nxt);
            if constexpr (SP2) {
            PG8_LDB(B0, 0, 0); PG8_LDB(B1, 0, 1); PG8_SCHED; PG8_LDA(At, 0, 0); PG8_STAGE(PG8_SA(1, 1), a1 + hstepA, voffA);
            PG8_WAIT_V(8); PG8_WAIT_L(0); PG8_BAR; PG8_MMA(0, 0, At, B0); PG8_MMA(0, 1, At, B1); PG8_BAR; PG8_SCHED;
            PG8_LDA(At, 0, 1); PG8_STAGE(PG8_SB(0, 0), b2, voffB); PG8_STAGE(PG8_SB(0, 1), b2 + hstepB, voffB); PG8_STAGE(PG8_SA(0, 0), a2, voffA);
            PG8_WAIT_V(8); PG8_WAIT_L(0); PG8_BAR; PG8_MMA(1, 0, At, B0); PG8_MMA(1, 1, At, B1); PG8_BAR; PG8_SCHED;
            PG8_LDB(B0, 1, 0); PG8_LDB(B1, 1, 1); PG8_SCHED; PG8_LDA(At, 1, 0); PG8_STAGE(PG8_SA(0, 1), a2 + hstepA, voffA);
            PG8_WAIT_V(8); PG8_WAIT_L(0); PG8_BAR; PG8_MMA(0, 0, At, B0); PG8_MMA(0, 1, At, B1); PG8_BAR; PG8_SCHED;
            PG8_LDA(At, 1, 1); PG8_STAGE(PG8_SB(1, 0), b3, voffB); PG8_STAGE(PG8_SB(1, 1), b3 + hstepB, voffB); PG8_STAGE(PG8_SA(1, 0), a3, voffA);
            PG8_WAIT_V(8); PG8_WAIT_L(0); PG8_BAR; PG8_MMA(1, 0, At, B0); PG8_MMA(1, 1, At, B1); PG8_BAR; PG8_SCHED;
            } else {
            PG8_LDB(B0, 0, 0); PG8_SCHED; PG8_LDA(At, 0, 0); PG8_STAGE(PG8_SA(1, 1), a1 + hstepA, voffA);
            PG8_WAIT_L(8); PG8_BAR; PG8_WAIT_L(0); PG8_MMA(0, 0, At, B0); PG8_BAR; PG8_SCHED;
            PG8_LDB(B1, 0, 1); PG8_STAGE(PG8_SB(0, 0), b2, voffB);
            PG8_BAR; PG8_WAIT_L(0); PG8_MMA(0, 1, At, B1); PG8_BAR;
            PG8_LDA(At, 0, 1); PG8_STAGE(PG8_SA(0, 0), a2, voffA);
            PG8_BAR; PG8_WAIT_L(0); PG8_MMA(1, 0, At, B0); PG8_BAR; PG8_SCHED;
            PG8_STAGE(PG8_SB(0, 1), b2 + hstepB, voffB);
            PG8_WAIT_V(6); PG8_BAR; PG8_MMA(1, 1, At, B1); PG8_BAR;
            PG8_LDB(B0, 1, 0); PG8_SCHED; PG8_LDA(At, 1, 0); PG8_STAGE(PG8_SA(0, 1), a2 + hstepA, voffA);
            PG8_WAIT_L(8); PG8_BAR; PG8_WAIT_L(0); PG8_MMA(0, 0, At, B0); PG8_BAR; PG8_SCHED;
            PG8_LDB(B1, 1, 1); PG8_STAGE(PG8_SB(1, 0), b3, voffB);
            PG8_BAR; PG8_WAIT_L(0); PG8_MMA(0, 1, At, B1); PG8_BAR;
            PG8_LDA(At, 1, 1); PG8_STAGE(PG8_SA(1, 0), a3, voffA);
            PG8_BAR; PG8_WAIT_L(0); PG8_MMA(1, 0, At, B0); PG8_BAR; PG8_SCHED;
            PG8_STAGE(PG8_SB(1, 1), b3 + hstepB, voffB);
            PG8_WAIT_V(6); PG8_BAR; PG8_MMA(1, 1, At, B1); PG8_BAR;
            }
        }
        if constexpr (ALIGN_EPI) { if (wr == 0) PG8_BAR; }
        if constexpr (!Epi::AFTER_DRAIN) { E(acc, cur, wr, wc, fr, fq); S.done(cur); }
        if (!has_next) break;
#pragma unroll
        for (int a = 0; a < 2; ++a)
#pragma unroll
            for (int b = 0; b < 2; ++b)
#pragma unroll
                for (int m = 0; m < 4; ++m)
#pragma unroll
                    for (int n = 0; n < 2; ++n) acc[a][b][m][n] = (f32x4){0.f, 0.f, 0.f, 0.f};
        cur = nxt; cA = nA; cB = nB; ++ui;
        if constexpr (ALIGN_EPI) { if (wr == 1) PG8_BAR; }
    }
    PG8_WAIT_V(0);
    if constexpr (!ALIGN_EPI) { if (wr == 0) PG8_BAR; }
    PG8_BAR;
    if constexpr (Epi::AFTER_DRAIN) { E.fused(acc, cur, wr, wc, fr, fq, lds, wid, lane); S.done(cur); }
#undef PG8_SA
#undef PG8_SB
#undef PG8_STAGE
#undef PG8_LDA
#undef PG8_LDB
#undef PG8_MMA
#undef PG8_WAIT_V
#undef PG8_WAIT_L
#undef PG8_BAR
#undef PG8_SCHED
}
}
#define GAS __attribute__((address_space(1)))
#define LAS __attribute__((address_space(3)))
typedef unsigned short bf16;
typedef unsigned v4u __attribute__((ext_vector_type(4)));
typedef float f32x4 __attribute__((ext_vector_type(4)));
typedef short bf16x8 __attribute__((ext_vector_type(8)));
typedef GAS unsigned gu32;
typedef GAS unsigned long long gu64;
#define RLX_AGENT __ATOMIC_RELAXED, __HIP_MEMORY_SCOPE_AGENT
#define LDS_WAIT() asm volatile("s_waitcnt lgkmcnt(0)" ::: "memory")
#define VM_WAIT() asm volatile("s_waitcnt vmcnt(0)" ::: "memory")
__device__ __forceinline__ unsigned long long rt() { return __builtin_amdgcn_s_memrealtime(); }
__device__ __forceinline__ unsigned f2bf(float f) { unsigned u = __builtin_bit_cast(unsigned, f); return (u + 0x7fffu + ((u >> 16) & 1u)) >> 16; }
__device__ __forceinline__ unsigned pk2(float lo, float hi) { return f2bf(lo) | (f2bf(hi) << 16); }

#define XB_TMO      128
#define XB_XCNT(j)  (256  + 64 * (j))
#define XB_XSUB(j)  (1280 + 64 * (j))
#define XB_XGEN(j)  (2304 + 64 * (j))
#define XB_TOP      3328
#define XB_TOPGEN   3392
#define XCD_BAR_WORDS 3456
#define XB_SPIN_CAP (1u << 18)

__device__ __forceinline__ unsigned xb_ld(unsigned* p)              { return __hip_atomic_load(p, __ATOMIC_RELAXED, __HIP_MEMORY_SCOPE_AGENT); }
__device__ __forceinline__ unsigned xb_add(unsigned* p, unsigned v) { return __hip_atomic_fetch_add(p, v, __ATOMIC_RELAXED, __HIP_MEMORY_SCOPE_AGENT); }
__device__ __forceinline__ unsigned xb_xcc_id() { return (unsigned)__builtin_amdgcn_s_getreg((3 << 11) | 20) & 0xFu; }
#define XB_SPIN(cond, bar) do { unsigned _sp = 0; while (cond) { __builtin_amdgcn_s_sleep(1); \
    if ((++_sp & 255u) == 0u) { if (xb_ld(&(bar)[XB_TMO])) break; if (_sp > XB_SPIN_CAP) { atomicAdd(&(bar)[XB_TMO], 1u); break; } } } } while (0)

struct XcdBarrier {
    unsigned* bar; unsigned x; bool w0; unsigned expect;
    volatile LAS unsigned* st;
};

__device__ __forceinline__ XcdBarrier xcd_barrier_post(unsigned* bar, volatile LAS unsigned* st) {
    XcdBarrier b; b.bar = bar; b.x = xb_xcc_id(); b.st = st; b.w0 = false; b.expect = 0u;
    if (threadIdx.x == 0) (void)xb_add(&bar[XB_XCNT(b.x)], 1u);
    return b;
}
__device__ __forceinline__ void xcd_barrier_complete(unsigned* bar, unsigned x, unsigned& nloc, unsigned& nx, const unsigned G) {
    unsigned sum, cnt, mine, sp = 0u;
    for (;;) {
        sum = 0u; cnt = 0u; mine = 0u;
#pragma unroll
        for (unsigned j = 0; j < 16; ++j) { const unsigned c = xb_ld(&bar[XB_XCNT(j)]); sum += c; cnt += (c > 0u) ? 1u : 0u; mine = (j == x) ? c : mine; }
        if (sum == G) break;
        __builtin_amdgcn_s_sleep(1);
        if ((++sp & 255u) == 0u) { if (xb_ld(&bar[XB_TMO])) break; if (sp > XB_SPIN_CAP) { atomicAdd(&bar[XB_TMO], 1u); break; } }
    }
    nloc = mine > 0u ? mine : 1u; nx = cnt > 0u ? cnt : 1u;
}

__device__ __forceinline__ void xcd_barrier(const XcdBarrier& b) {
    asm volatile("s_waitcnt vmcnt(0)" ::: "memory");
    __syncthreads();
    if (b.w0 && lane_now() == 0) {
        unsigned* bar = b.bar;
        __builtin_amdgcn_s_waitcnt(0);
        unsigned nloc = b.st[0], nx = b.st[1];
        if (nloc == 0u) { xcd_barrier_complete(bar, b.x, nloc, nx, b.expect); b.st[0] = nloc; b.st[1] = nx; }
        const unsigned old = xb_add(&bar[XB_XSUB(b.x)], 1u);
        const unsigned gen = old / nloc;
        if (old + 1u == (gen + 1u) * nloc) {
            __builtin_amdgcn_fence(__ATOMIC_RELEASE, "agent");
            asm volatile("s_waitcnt vmcnt(0)" ::: "memory");
            if (nx > 1u) {
            const unsigned og = xb_add(&bar[XB_TOP], 1u);
            const unsigned tg = og / nx;
            if (og + 1u == (tg + 1u) * nx) xb_add(&bar[XB_TOPGEN], 1u);
            else XB_SPIN(xb_ld(&bar[XB_TOPGEN]) == tg, bar);
            }
            __builtin_amdgcn_fence(__ATOMIC_ACQUIRE, "agent");
            xb_add(&bar[XB_XGEN(b.x)], 1u);
            asm volatile("s_waitcnt vmcnt(0)" ::: "memory");
        } else {
            XB_SPIN(xb_ld(&bar[XB_XGEN(b.x)]) == gen, bar);
            __builtin_amdgcn_fence(__ATOMIC_ACQUIRE, "agent");
            asm volatile("s_waitcnt vmcnt(0)" ::: "memory");
        }
    }
    __syncthreads();
}
constexpr int NWAVES = 8;
constexpr int BATCH = 4, SEQ = 4096, D = 2048, DEPTH = 4, M = BATCH * SEQ, FF = 5632, NIN = 5152, NINP = 5376, NMOD = 9, MODW = NMOD * D;
constexpr int RET_H = 4, RET_DK = 128, RET_DV = 256, S5_W = 512, S5_G = 32, S5_P = 64, S5_C = 16, GLA_H = 4, GLA_DK = 64, GLA_DV = 128, GLA_R = 16;
constexpr int PC_RQ = 0, PC_RK = 512, PC_RV = 1024, PC_RG = 2048, PC_SU = 3072, PC_GQ = 3584, PC_GK = 3840, PC_GV = 4096, PC_GR = 4608, PC_LR = 5120;
constexpr float EPS = 1e-6f;
constexpr size_t MiB = 1u << 20;
constexpr size_t WS_CTL = 0, CTL_ZERO_BYTES = 2 * MiB;
constexpr size_t WS_MOD = 2 * MiB;
constexpr size_t WS_ROT = 4 * MiB;
constexpr size_t WS_S5L = 6 * MiB;
constexpr size_t WS_S5B = 7 * MiB;
constexpr size_t WS_LA = 16 * MiB;
constexpr size_t WS_H = 48 * MiB;
constexpr size_t WS_U = 176 * MiB;
constexpr size_t WS_Y = 240 * MiB;
constexpr size_t WS_Z = 304 * MiB;
constexpr size_t WS_G = 320 * MiB;
constexpr size_t WS_PROJ = 496 * MiB;
constexpr size_t WS_ORET = 664 * MiB;
constexpr size_t WS_OGLA = 728 * MiB;
constexpr size_t WS_YS5 = 760 * MiB;
constexpr size_t WS_W = 800 * MiB;
constexpr size_t LW_13A = 0, LW_2A = 44 * MiB, LW_IN = 66 * MiB, LW_OUT = 87 * MiB, LW_GLU = 95 * MiB, LW_13B = 96 * MiB, LW_2B = 140 * MiB, LW_STRIDE = 162 * MiB;
constexpr size_t WS_S5LT = 10 * MiB;
constexpr size_t WS_SC = 1448 * MiB;
constexpr size_t WS_SUA = 1464 * MiB;
constexpr size_t WS_W1 = 1488 * MiB;
constexpr size_t WS_MF = 1520 * MiB;
constexpr size_t WS_KV_R = 1616 * MiB;
constexpr size_t WS_KV_G = 1744 * MiB;
constexpr size_t WS_DEC_R = 1776 * MiB;
constexpr size_t WS_DEC_G = 1777 * MiB;
constexpr int LDG = 5696;
constexpr size_t WS_G2 = 1792 * MiB;
constexpr size_t WS_W2P = 1984 * MiB;
constexpr size_t WS_END = 2176 * MiB;
static_assert(WS_W + DEPTH * LW_STRIDE <= WS_SC, "ws map");
constexpr int CW_BAR = 4096;
constexpr int MAX_BAR_REGIONS = 128;
constexpr int RING_OFF = 0, RING_BYTES = 131072;
constexpr int LDS_BYTES = 163840;
constexpr int LDSCTL_OFF = LDS_BYTES - 1024, MISC_OFF = LDSCTL_OFF + 320;
constexpr int CHUNK_LDS_MAX = LDSCTL_OFF;

struct Frame {
    LAS unsigned char* lds;
    volatile LAS unsigned* MISC;
    gu32* ctl;
    int tid, lane, wave;
    int vcu, G;
    int nt, hf, T, tr, tv;
};

__device__ __forceinline__ float wave_sum(float v) {
#pragma unroll
    for (int o = 1; o < 64; o <<= 1) v += __shfl_xor(v, o);
    return v;
}
__device__ __forceinline__ float wave_sum_l(float v, int lane) {
#pragma unroll
    for (int o = 1; o < 64; o <<= 1) v += __int_as_float(__builtin_amdgcn_ds_bpermute((lane ^ o) << 2, __float_as_int(v)));
    return v;
}
typedef __bf16 hbf2 __attribute__((ext_vector_type(2))); typedef float f32x2h __attribute__((ext_vector_type(2)));
__device__ __forceinline__ unsigned pkh(float lo, float hi) { const f32x2h v = {lo, hi}; return __builtin_bit_cast(unsigned, __builtin_convertvector(v, hbf2)); }
__device__ __forceinline__ float bf2f(bf16 b) { return __uint_as_float(((unsigned)b) << 16); }

struct TrItem { const float* W; bf16* WT; int N, ldw, rowbase, k0, n0; };
__device__ __forceinline__ void p0_tr_load(const TrItem& t, float (&wv)[32], int lane) {
#pragma unroll
    for (int i = 0; i < 32; ++i) wv[i] = t.W[(size_t)(t.k0 + 2 * i + (lane >> 5)) * t.N + t.n0 + (lane & 31)];
}
__device__ __forceinline__ void p0_tr_store(const TrItem& t, const float (&wv)[32], LAS float* scr, int lane) {
#pragma unroll
    for (int i = 0; i < 32; ++i) scr[(2 * i + (lane >> 5)) * 33 + (lane & 31)] = wv[i];
    LDS_WAIT(); asm volatile("" ::: "memory");
    const int c = lane & 7;
#pragma unroll
    for (int j = 0; j < 4; ++j) { const int n = (lane >> 3) + 8 * j; const LAS float* s = scr + (8 * c) * 33 + n;
        v4u o; o.x = pkh(s[0 * 33], s[1 * 33]); o.y = pkh(s[2 * 33], s[3 * 33]); o.z = pkh(s[4 * 33], s[5 * 33]); o.w = pkh(s[6 * 33], s[7 * 33]);
        *(GAS v4u*)(t.WT + (size_t)(t.rowbase + n) * t.ldw + t.k0 + 8 * c) = o; }
    LDS_WAIT(); asm volatile("" ::: "memory");
}

struct Args {
    const float* in[28]; float* out; unsigned char* ws;
    int ph_lo, ph_hi, li, pad;
};
typedef const __attribute__((address_space(4))) Args* KArgsP;
__device__ __forceinline__ KArgsP kargs() { KArgsP p = (KArgsP)__builtin_amdgcn_kernarg_segment_ptr(); asm volatile("" : "+s"(p)); return p; }
#define WSP(off) ((unsigned char*)kargs()->ws + (off))
#define INP(i) ((const float*)kargs()->in[i])
enum { I_X = 0, I_C, I_WADA, I_BADA, I_GFFN1, I_F1W1, I_F1W3, I_F1W2, I_GMIX, I_WIN, I_LRE, I_LIM, I_LDT, I_BRE, I_BIM, I_CRE, I_CIM, I_S5D, I_WGLU, I_BGLU, I_WGATE, I_BGATE, I_WOUT, I_GFFN2, I_F2W1, I_F2W3, I_F2W2, I_GFINAL };

__device__ __forceinline__ void p0_prologue(Frame& F) {
    unsigned char* ws = (unsigned char*)kargs()->ws;
    {
        LAS float* cond = (LAS float*)(F.lds + RING_OFF);
        LAS float* red = (LAS float*)(F.lds + RING_OFF + 32768);
        const float* c = kargs()->in[I_C];
        for (int i = F.tid; i < BATCH * D; i += NWAVES * 64) { const int b = i / D, k = i % D; const float v = c[i]; cond[k * 4 + b] = v / (1.0f + __expf(-v)); }
        __syncthreads();
        float* mod = (float*)(ws + WS_MOD);
        constexpr int NCB = MODW / 32;
        const int lane = lane_now(), col = lane & 31, kh = lane >> 5;
        for (int it = F.vcu; it < DEPTH * NCB; it += F.G) {
            const int l = it / NCB, j0 = (it % NCB) * 32;
            const int kb = F.wave * 256;
            const float* W = kargs()->in[I_WADA] + (size_t)l * D * MODW + (size_t)(kb + kh) * MODW + j0 + col;
            float acc0 = 0.f, acc1 = 0.f, acc2 = 0.f, acc3 = 0.f;
            float wv[2][32];
#pragma unroll
            for (int k = 0; k < 32; ++k) wv[0][k] = W[(size_t)(2 * k) * MODW];
#pragma unroll
            for (int ch = 0; ch < 4; ++ch) {
                if (ch < 3) {
#pragma unroll
                    for (int k = 0; k < 32; ++k) wv[(ch + 1) & 1][k] = W[(size_t)(64 * (ch + 1) + 2 * k) * MODW]; }
#pragma unroll
                for (int k = 0; k < 32; ++k) { const f32x4 cv = *(const LAS f32x4*)(cond + (kb + 64 * ch + 2 * k + kh) * 4); const float w = wv[ch & 1][k]; acc0 += cv[0] * w; acc1 += cv[1] * w; acc2 += cv[2] * w; acc3 += cv[3] * w; } }
            red[(F.wave * 4 + 0) * 64 + lane] = acc0; red[(F.wave * 4 + 1) * 64 + lane] = acc1; red[(F.wave * 4 + 2) * 64 + lane] = acc2; red[(F.wave * 4 + 3) * 64 + lane] = acc3;
            __syncthreads();
            if (F.tid < 128) { const int b = F.tid >> 5, cc = F.tid & 31; float s = 0.f;
#pragma unroll
                for (int w = 0; w < 8; ++w) s += red[(w * 4 + b) * 64 + cc] + red[(w * 4 + b) * 64 + 32 + cc];
                mod[((size_t)l * BATCH + b) * MODW + j0 + cc] = s + kargs()->in[I_BADA][(size_t)l * MODW + j0 + cc]; }
            __syncthreads();
        }
    }
    __syncthreads();
    const int gw = F.vcu * NWAVES + F.wave, NGW = F.G * NWAVES;
    const int gt = gw * 64 + F.lane, NGT = NGW * 64;
    {
        float* rc = (float*)(ws + WS_ROT); float* rs = rc + SEQ * 64;
        for (int i = gt; i < SEQ * 64; i += NGT) { const int pos = i >> 6, j = i & 63; const float invf = powf(10000.0f, -(float)(2 * j) / 128.0f); const float ang = (float)pos * invf; rc[i] = cosf(ang); rs[i] = sinf(ang); }
    }
    {
        typedef float f32x2 __attribute__((ext_vector_type(2)));
        LAS f32x2* POW = (LAS f32x2*)(F.lds + RING_OFF);
        LAS f32x2* BBl = (LAS f32x2*)(F.lds + RING_OFF + 33792);
        LAS f32x2* CCl = (LAS f32x2*)(F.lds + RING_OFF + 33792 + 16384);
        LAS float* KT = (LAS float*)(F.lds + RING_OFF + 33792 + 32768);
        for (int it = F.vcu; it < DEPTH * S5_G * 2; it += F.G) {
            const int l = it / (2 * S5_G), g = (it >> 1) % S5_G, hd = it & 1;
            __syncthreads();
            for (int i = F.tid; i < 33 * 64; i += NWAVES * 64) { const int p = i & 63, k = i >> 6; const int gi = ((l * 2 + hd) * S5_G + g) * S5_P + p;
                const float dt = expf(kargs()->in[I_LDT][(l * 2 + hd) * S5_G + g]); const float zr = kargs()->in[I_LRE][gi] * dt * (float)k, zi = kargs()->in[I_LIM][gi] * dt * (float)k; const float e = expf(zr);
                const f32x2 v = (f32x2){e * cosf(zi), e * sinf(zi)}; POW[hd * 33 * 64 + i] = v;
                if (k == 32) { float* lt = (float*)(ws + WS_S5LT); lt[2 * gi] = v.x; lt[2 * gi + 1] = v.y; } }
            for (int i = F.tid + hd * 1024; i < 2 * 64 * 16; i += NWAVES * 64) { const int c = i & 15, p = (i >> 4) & 63, dir = i >> 10; const int gi = ((l * 2 + dir) * S5_G + g) * S5_P + p;
                const float lre = kargs()->in[I_LRE][gi], lim = kargs()->in[I_LIM][gi], dt = expf(kargs()->in[I_LDT][(l * 2 + dir) * S5_G + g]); const float e = expf(lre * dt); const float br = e * cosf(lim * dt), bi = e * sinf(lim * dt);
                const float nr = br - 1.0f, ni = bi, den = lre * lre + lim * lim; const float cr = (nr * lre + ni * lim) / den, ci = (ni * lre - nr * lim) / den;
                const float xr = kargs()->in[I_BRE][(size_t)gi * 16 + c], xi = kargs()->in[I_BIM][(size_t)gi * 16 + c]; BBl[i] = (f32x2){cr * xr - ci * xi, cr * xi + ci * xr}; }
            for (int i = F.tid + hd * 1024; i < 2 * 16 * 64; i += NWAVES * 64) { const int p = i & 63, c = (i >> 6) & 15, dir = i >> 10; const size_t gi = ((size_t)((l * 2 + dir) * S5_G + g) * 16 + c) * S5_P + p;
                CCl[i] = (f32x2){kargs()->in[I_CRE][gi], kargs()->in[I_CIM][gi]}; }
            __syncthreads();
            { const int c = F.tid & 15, cp = (F.tid >> 4) & 15, k0 = (F.tid >> 8) ? 0 : 1; float cbx[64], cby[64];
#pragma unroll
              for (int p = 0; p < 64; ++p) { const f32x2 cc = CCl[(hd * 16 + cp) * 64 + p], bb = BBl[(hd * 64 + p) * 16 + c]; cbx[p] = cc.x * bb.x - cc.y * bb.y; cby[p] = cc.x * bb.y + cc.y * bb.x; }
              for (int k = k0 + 2 * (hd & (k0 == 0)); k < 32; k += 2) { const LAS f32x4* pw = (const LAS f32x4*)(POW + (hd * 33 + k) * 64); float a0 = 0.f, a1 = 0.f;
#pragma unroll
                  for (int p2 = 0; p2 < 32; ++p2) { const f32x4 w = pw[p2]; a0 += cbx[2 * p2] * w.x - cby[2 * p2] * w.y; a1 += cbx[2 * p2 + 1] * w.z - cby[2 * p2 + 1] * w.w; }
                  float acc = a0 + a1;
                  if (k == 0) { if (c == cp) acc += kargs()->in[I_S5D][l * S5_W + g * 16 + c];
                      for (int p = 0; p < 64; ++p) { const f32x2 cc = CCl[(16 + cp) * 64 + p], bb = BBl[(64 + p) * 16 + c]; acc += cc.x * bb.x - cc.y * bb.y; } }
                  KT[(((hd == 0 ? k : -k) + 31) * 16 + cp) * 16 + c] = acc; } }
            __syncthreads();
            { bf16* W1 = (bf16*)(ws + WS_W1) + (size_t)(l * S5_G + g) * 256 * 512;
              for (int i = F.tid; i < 128 * 64; i += NWAVES * 64) { const int kv = i & 63, pp = hd * 128 + (i >> 6), part = pp >> 6, p = pp & 63, s = kv >> 1, c0 = (kv & 1) * 8; const int e = hd == 0 ? 31 - s : s;
                  const f32x2 pw = POW[(hd * 33 + e) * 64 + p]; float o[8];
#pragma unroll
                  for (int j = 0; j < 8; ++j) { const f32x2 bb = BBl[(hd * 64 + p) * 16 + c0 + j]; o[j] = (part & 1) ? (pw.x * bb.y + pw.y * bb.x) : (pw.x * bb.x - pw.y * bb.y); }
                  v4u w; w.x = pkh(o[0], o[1]); w.y = pkh(o[2], o[3]); w.z = pkh(o[4], o[5]); w.w = pkh(o[6], o[7]); *(GAS v4u*)(W1 + (size_t)pp * 512 + kv * 8) = w; } }
            { bf16* MF = (bf16*)(ws + WS_MF) + (size_t)(l * S5_G + g) * 512 * 768;
              for (int i = F.tid; i < 512 * 96; i += NWAVES * 64) { const int kv = i % 96, r = i / 96, t = r >> 4, cp = r & 15; float o[8];
                  if (kv < 64) { const int s = kv >> 1, c0 = (kv & 1) * 8; if ((t >= s) != (hd == 0)) continue; const LAS float* kt = KT + ((t - s + 31) * 16 + cp) * 16 + c0;
#pragma unroll
                      for (int j = 0; j < 8; ++j) o[j] = kt[j]; }
                  else { const int pp0 = (kv - 64) * 8, part = pp0 >> 6, dir = part >> 1, e = dir == 0 ? t + 1 : 32 - t; if (dir != hd) continue;
#pragma unroll
                      for (int j = 0; j < 8; ++j) { const int p = (pp0 & 63) + j; const f32x2 cc = CCl[(dir * 16 + cp) * 64 + p], pw = POW[(dir * 33 + e) * 64 + p];
                          o[j] = (part & 1) ? -(cc.x * pw.y + cc.y * pw.x) : (cc.x * pw.x - cc.y * pw.y); } }
                  v4u w; w.x = pkh(o[0], o[1]); w.y = pkh(o[2], o[3]); w.z = pkh(o[4], o[5]); w.w = pkh(o[6], o[7]); *(GAS v4u*)(MF + (size_t)r * 768 + kv * 8) = w; } }
        }
        __syncthreads();
    }
    {
        LAS float* scr = (LAS float*)(F.lds + RING_OFF + F.wave * 16384);
        constexpr int I_FF = (D / 64) * (FF / 32);
        constexpr int I_W2 = (FF / 64) * (D / 32);
        constexpr int I_IN = (D / 64) * (NIN / 32);
        constexpr int I_OUT = (D / 64) * (D / 32);
        constexpr int I_GLU = (S5_W / 64) * (S5_W / 32);
        constexpr int PER_L = 4 * I_FF + 2 * I_W2 + I_IN + I_OUT + I_GLU;
        auto decode = [&](int it, TrItem& t) {
            const int l = it / PER_L; int r = it % PER_L;
            unsigned char* wl = ws + WS_W + (size_t)l * LW_STRIDE;
            int K; int mode = 0; t.ldw = 0;
            if (r < I_FF) { t.W = kargs()->in[I_F1W1] + (size_t)l * D * FF; K = D; t.N = FF; t.WT = (bf16*)(wl + LW_13A); mode = 1; }
            else if ((r -= I_FF) < I_FF) { t.W = kargs()->in[I_F1W3] + (size_t)l * D * FF; K = D; t.N = FF; t.WT = (bf16*)(wl + LW_13A); mode = 2; }
            else if ((r -= I_FF) < I_W2) { t.W = kargs()->in[I_F1W2] + (size_t)l * FF * D; K = FF; t.N = D; t.WT = (bf16*)(ws + WS_W2P) + (size_t)(l * 2 + 0) * D * LDG; t.ldw = LDG; }
            else if ((r -= I_W2) < I_FF) { t.W = kargs()->in[I_F2W1] + (size_t)l * D * FF; K = D; t.N = FF; t.WT = (bf16*)(wl + LW_13B); mode = 1; }
            else if ((r -= I_FF) < I_FF) { t.W = kargs()->in[I_F2W3] + (size_t)l * D * FF; K = D; t.N = FF; t.WT = (bf16*)(wl + LW_13B); mode = 2; }
            else if ((r -= I_FF) < I_W2) { t.W = kargs()->in[I_F2W2] + (size_t)l * FF * D; K = FF; t.N = D; t.WT = (bf16*)(ws + WS_W2P) + (size_t)(l * 2 + 1) * D * LDG; t.ldw = LDG; }
            else if ((r -= I_W2) < I_IN) { t.W = kargs()->in[I_WIN] + (size_t)l * D * NIN; K = D; t.N = NIN; t.WT = (bf16*)(wl + LW_IN); mode = 3; }
            else if ((r -= I_IN) < I_OUT) { t.W = kargs()->in[I_WOUT] + (size_t)l * D * D; K = D; t.N = D; t.WT = (bf16*)(wl + LW_OUT); }
            else { r -= I_OUT; t.W = kargs()->in[I_WGLU] + (size_t)l * S5_W * S5_W; K = S5_W; t.N = S5_W; t.WT = (bf16*)(wl + LW_GLU); }
            if (!t.ldw) t.ldw = K;
            const int nblk = t.N / 32, kb = r / nblk, nb = r % nblk; t.k0 = 64 * kb; t.n0 = 32 * nb;
            t.rowbase = t.n0;
            if (mode == 1 || mode == 2) t.rowbase = 256 * (t.n0 / 128) + (t.n0 % 128) + (mode == 2 ? 128 : 0);
            if (mode == 3 && t.n0 < 1024) { const int cl = t.n0 & 255, d0 = cl & 127; t.rowbase = (t.n0 & ~255) + 128 * (d0 >> 6) + 64 * (cl >> 7) + (d0 & 63); }
        };
        const int lane = lane_now();
        if (gw < DEPTH * PER_L) {
            constexpr int TOT = DEPTH * PER_L;
            TrItem ta, tb; float wa[32], wb[32]; decode(gw, ta); p0_tr_load(ta, wa, lane);
            for (int it = gw; ; it += 2 * NGW) {
                const int i1 = it + NGW; const bool has1 = i1 < TOT;
                decode(has1 ? i1 : it, tb); p0_tr_load(tb, wb, lane);
                p0_tr_store(ta, wa, scr, lane);
                if (!has1) break;
                const int i2 = it + 2 * NGW; const bool has2 = i2 < TOT;
                decode(has2 ? i2 : it, ta); p0_tr_load(ta, wa, lane);
                p0_tr_store(tb, wb, scr, lane);
                if (!has2) break;
            }
        }
        constexpr int PADV = (NINP - NIN) * D * 2 / 16;
        for (int i = gt; i < DEPTH * PADV; i += NGT) { const int l = i / PADV, r = i % PADV;
            *(GAS v4u*)(ws + WS_W + (size_t)l * LW_STRIDE + LW_IN + (size_t)NIN * D * 2 + (size_t)r * 16) = (v4u){0u, 0u, 0u, 0u}; }
    }
}

template <bool SRC16> __device__ __forceinline__ void norm_mod_phase(Frame& F, const void* srcv, const float* g, const float* shift, const float* scale, bf16* U, h16* h16out) {
    constexpr int R = 4;
    const int lane = lane_now();
    int gw = F.tv * NWAVES + F.wave; asm volatile("" : "+s"(gw)); const int NGW = F.T * NWAVES; const int m0 = F.hf * (M / F.nt);
    const bool contig = (NGW * 8 == M / F.nt);
    for (int k = 0, mb = m0 + gw * (contig ? 8 : R); contig ? k < 8 / R : mb < m0 + M / F.nt; ++k, mb += contig ? R : NGW * R) {
        const int b = mb / SEQ;
        f32x4 v[R][8]; float rstd[R];
        if constexpr (SRC16) { h16x4 raw[R][8];
#pragma unroll
            for (int r = 0; r < R; ++r) { const GAS h16x4* xr = (const GAS h16x4*)((const h16*)srcv + (size_t)(mb + r) * D) + lane;
#pragma unroll
                for (int j = 0; j < 8; ++j) raw[r][j] = xr[64 * j]; }
#pragma unroll
            for (int r = 0; r < R; ++r)
#pragma unroll
                for (int j = 0; j < 8; ++j) v[r][j] = __builtin_convertvector(raw[r][j], f32x4); }
        else {
#pragma unroll
            for (int r = 0; r < R; ++r) { const GAS f32x4* xr = (const GAS f32x4*)((const float*)srcv + (size_t)(mb + r) * D) + lane; GAS h16x4* ho = (GAS h16x4*)(h16out + (size_t)(mb + r) * D) + lane;
#pragma unroll
                for (int j = 0; j < 8; ++j) { v[r][j] = xr[64 * j]; ho[64 * j] = __builtin_convertvector(v[r][j], h16x4); } } }
#pragma unroll
        for (int r = 0; r < R; ++r) { float s = 0.f;
#pragma unroll
            for (int j = 0; j < 8; ++j) s += (v[r][j].x * v[r][j].x + v[r][j].y * v[r][j].y) + (v[r][j].z * v[r][j].z + v[r][j].w * v[r][j].w);
            rstd[r] = __builtin_amdgcn_rsqf(wave_sum_l(s, lane) * (1.0f / D) + EPS); }
        const GAS f32x4* gp = (const GAS f32x4*)g + lane; const GAS f32x4* sh = (const GAS f32x4*)(shift + (size_t)b * MODW) + lane; const GAS f32x4* sc = (const GAS f32x4*)(scale + (size_t)b * MODW) + lane;
#pragma unroll
        for (int j = 0; j < 8; ++j) { const f32x4 gg = gp[64 * j], hh = sh[64 * j], cc = sc[64 * j] + 1.0f;
#pragma unroll
            for (int r = 0; r < R; ++r) { const f32x4 o = ((v[r][j] * rstd[r]) * gg) * cc + hh;
                ((GAS unsigned long long*)(U + (size_t)(mb + r) * D) + lane)[64 * j] = (unsigned long long)pkh(o.x, o.y) | ((unsigned long long)pkh(o.z, o.w) << 32); } }
    }
}
__device__ __forceinline__ void final_norm_phase(Frame& F, const h16* src, const float* g, float* out) {
    constexpr int R = 4;
    const int lane = lane_now();
    int gw = F.tv * NWAVES + F.wave; asm volatile("" : "+s"(gw)); const int NGW = F.T * NWAVES; const int m0 = F.hf * (M / F.nt);
    const bool contig = (NGW * 8 == M / F.nt);
    for (int k = 0, mb = m0 + gw * (contig ? 8 : R); contig ? k < 8 / R : mb < m0 + M / F.nt; ++k, mb += contig ? R : NGW * R) {
        h16x4 raw[R][8];
#pragma unroll
        for (int r = 0; r < R; ++r) { const GAS h16x4* xr = (const GAS h16x4*)(src + (size_t)(mb + r) * D) + lane;
#pragma unroll
            for (int j = 0; j < 8; ++j) raw[r][j] = xr[64 * j]; }
        const GAS f32x4* gp = (const GAS f32x4*)g + lane;
#pragma unroll
        for (int r = 0; r < R; ++r) { f32x4 v[8]; float s = 0.f;
#pragma unroll
            for (int j = 0; j < 8; ++j) { v[j] = __builtin_convertvector(raw[r][j], f32x4); s += (v[j].x * v[j].x + v[j].y * v[j].y) + (v[j].z * v[j].z + v[j].w * v[j].w); }
            const float rstd = __builtin_amdgcn_rsqf(wave_sum_l(s, lane) * (1.0f / D) + EPS);
            GAS f32x4* o = (GAS f32x4*)(out + (size_t)(mb + r) * D) + lane;
#pragma unroll
            for (int j = 0; j < 8; ++j) o[64 * j] = (v[j] * rstd) * gp[64 * j]; }
    }
}

#define LDS_BAR() do { asm volatile("s_waitcnt lgkmcnt(0)" ::: "memory"); __builtin_amdgcn_s_barrier(); asm volatile("" ::: "memory"); } while (0)
__device__ __forceinline__ void s5_scan_phase(Frame& F, int l) {
    const int lane = lane_now(); const int wave = F.wave;
    unsigned char* ws = (unsigned char*)kargs()->ws;
    const float* SC = (const float*)(ws + WS_SC); bf16* SUA = (bf16*)(ws + WS_SUA); const float* LT = (const float*)(ws + WS_S5LT);
    typedef float f32x2_ __attribute__((ext_vector_type(2)));
    LAS f32x2_* EX = (LAS f32x2_*)(F.lds + RING_OFF);
    const int nbt = BATCH / F.nt;
    for (int it = F.tv; it < S5_G * nbt * 2; it += F.T) {
        const int dir = it & 1, b = F.hf * nbt + (it >> 1) % nbt, g = (it >> 1) / nbt, p = lane;
        const int gi = ((l * 2 + dir) * S5_G + g) * S5_P + p; const float lr = LT[2 * gi], li = LT[2 * gi + 1];
        float sr[16], si[16];
#pragma unroll
        for (int t = 0; t < 16; ++t) { const int jj = 16 * wave + t, n = dir == 0 ? jj : 127 - jj; const size_t row = (size_t)g * 512 + b * 128 + n; sr[t] = SC[row * 256 + dir * 128 + p]; si[t] = SC[row * 256 + dir * 128 + 64 + p]; }
        float xr = 0.f, xi = 0.f;
#pragma unroll
        for (int t = 0; t < 16; ++t) { const float a = sr[t], c = si[t]; sr[t] = xr; si[t] = xi; const float nr = lr * xr - li * xi + a, ni = lr * xi + li * xr + c; xr = nr; xi = ni; }
        EX[wave * 64 + lane] = (f32x2_){xr, xi};
        float ar = lr, ai = li;
#pragma unroll
        for (int q = 0; q < 4; ++q) { const float t0 = ar * ar - ai * ai, t1 = 2.0f * ar * ai; ar = t0; ai = t1; }
        LDS_BAR();
        float cr = 0.f, ci = 0.f;
        for (int v = 0; v < wave; ++v) { const f32x2_ e = EX[v * 64 + lane]; const float nr = ar * cr - ai * ci + e.x, ni = ar * ci + ai * cr + e.y; cr = nr; ci = ni; }
        float pr = 1.0f, pi = 0.f;
#pragma unroll
        for (int t = 0; t < 16; ++t) { const int jj = 16 * wave + t, n = dir == 0 ? jj : 127 - jj; const size_t row = (size_t)g * 512 + b * 128 + n;
            SUA[row * 768 + 512 + dir * 128 + p] = (bf16)f2bf(sr[t] + pr * cr - pi * ci); SUA[row * 768 + 512 + dir * 128 + 64 + p] = (bf16)f2bf(si[t] + pr * ci + pi * cr);
            const float t0 = pr * lr - pi * li, t1 = pr * li + pi * lr; pr = t0; pi = t1; }
        LDS_BAR();
    }
}
typedef short s16x4 __attribute__((ext_vector_type(4)));
typedef float f32x2 __attribute__((ext_vector_type(2)));
template <int DK_, int DV_, bool SCALAR_> struct ChunkCfg { static constexpr int DK = DK_, DV = DV_, C = 64; static constexpr bool SCALAR = SCALAR_;
    static constexpr int PK = DK * 2 + 32, PV = DV * 2 + 32;
    static constexpr int T0 = 0, T1 = C * PK, T2 = 2 * C * PK, T3 = 3 * C * PK, VT = 4 * C * PK, BF = VT + C * PV, BB = BF + (SCALAR ? 0 : C * DK * 4), LR = BB + (SCALAR ? 0 : C * DK * 4),
                         WG = LR + (SCALAR ? 0 : C * 32 * 4), BG = WG + (SCALAR ? 0 : 2 * 16 * DK * 4), SEG = BG + (SCALAR ? 0 : 2 * DK * 4), PT = SEG + (SCALAR ? 0 : 2 * 8 * DK * 4), RED = PT + C * 160, END = RED + 8 * 64 * 8;
    static_assert(END <= RING_BYTES, "chunk LDS"); };
struct ChunkArgs { const bf16* proj; int qoff, koff, voff, goff; bf16* kv; float* dec; bf16* Y; int yoff; const float* wg; const float* bg; const float* lab; };
__device__ __forceinline__ bf16x8 tr_pair(const LAS unsigned char* p0, const LAS unsigned char* p1) {
    const s16x4 a = __builtin_amdgcn_ds_read_tr16_b64_v4i16((LAS s16x4*)p0), b = __builtin_amdgcn_ds_read_tr16_b64_v4i16((LAS s16x4*)p1);
    return __builtin_shufflevector(a, b, 0, 1, 2, 3, 4, 5, 6, 7); }
__device__ __forceinline__ float xlane_add(float v, int lane, int o) { return v + __int_as_float(__builtin_amdgcn_ds_bpermute((lane ^ o) << 2, __float_as_int(v))); }

typedef unsigned u32x2 __attribute__((ext_vector_type(2)));
__device__ __forceinline__ void unpack8(const v4u w, float (&f)[8]) {
#pragma unroll
    for (int j = 0; j < 4; ++j) { f[2 * j] = __uint_as_float(w[j] << 16); f[2 * j + 1] = __uint_as_float(w[j] & 0xffff0000u); } }
__device__ __forceinline__ v4u pack8(const float (&f)[8]) { v4u w; w.x = pkh(f[0], f[1]); w.y = pkh(f[2], f[3]); w.z = pkh(f[4], f[5]); w.w = pkh(f[6], f[7]); return w; }
template <class Cfg> __device__ __forceinline__ void chunk_decays(LAS unsigned char* lds, const ChunkArgs& A, int tid, int h, int& hprev, u32x2 lrw) {
    if constexpr (!Cfg::SCALAR) {
        constexpr int DK = Cfg::DK;
        LAS float* LRs = (LAS float*)(lds + Cfg::LR); LAS float* WGs = (LAS float*)(lds + Cfg::WG); LAS float* BGs = (LAS float*)(lds + Cfg::BG); LAS float* BFs = (LAS float*)(lds + Cfg::BF); LAS float* BBs = (LAS float*)(lds + Cfg::BB);
        if (h != hprev) { hprev = h;
            for (int i = tid; i < 2 * 16 * DK; i += 512) { const int d = i % DK, r = (i / DK) & 15, dir = i / (16 * DK); WGs[i] = A.wg[(dir * 16 + r) * 256 + h * DK + d]; }
            if (tid < 2 * DK) BGs[tid] = A.bg[(tid / DK) * 256 + h * DK + (tid % DK)]; }
        { LAS float* o = LRs + (tid >> 3) * 32 + (tid & 7) * 4; o[0] = __uint_as_float(lrw.x << 16); o[1] = __uint_as_float(lrw.x & 0xffff0000u); o[2] = __uint_as_float(lrw.y << 16); o[3] = __uint_as_float(lrw.y & 0xffff0000u); }
        LDS_BAR();
        { constexpr int PER = 64 * DK / 512;
          const int d = tid % DK, tb = tid / DK;
#pragma unroll
          for (int dir = 0; dir < 2; ++dir) { float wgr[16];
#pragma unroll
              for (int r = 0; r < 16; ++r) wgr[r] = WGs[(dir * 16 + r) * DK + d];
              const float bgv = BGs[dir * DK + d]; LAS float* o = dir == 0 ? BFs : BBs;
#pragma unroll
              for (int k = 0; k < PER; ++k) { const int t = tb + (512 / DK) * k; float s = bgv;
#pragma unroll
                  for (int r = 0; r < 16; r += 4) { const f32x4 lr4 = *(const LAS f32x4*)(LRs + t * 32 + dir * 16 + r); s += lr4[0] * wgr[r] + lr4[1] * wgr[r + 1] + lr4[2] * wgr[r + 2] + lr4[3] * wgr[r + 3]; }
                  o[t * DK + d] = (fminf(s, 0.f) - __logf(1.0f + __expf(-fabsf(s)))) * (1.0f / 16.0f); } } }
        LDS_BAR();
        LAS float* SG = (LAS float*)(lds + Cfg::SEG);
        for (int i = tid; i < 2 * 8 * DK; i += 512) { const int d = i % DK, sg = (i / DK) & 7, dir = i / (8 * DK); LAS float* a = (dir == 0 ? BFs : BBs); float run = 0.f;
            if (dir == 0) { for (int t = 8 * sg; t < 8 * sg + 8; ++t) { run += a[t * DK + d]; a[t * DK + d] = run; } }
            else { for (int t = 8 * sg + 7; t >= 8 * sg; --t) { run += a[t * DK + d]; a[t * DK + d] = run; } }
            SG[i] = run; }
        LDS_BAR();
        for (int i = tid; i < 2 * 8 * DK; i += 512) { const int d = i % DK, sg = (i / DK) & 7, dir = i / (8 * DK); LAS float* a = (dir == 0 ? BFs : BBs); float off = 0.f;
            if (dir == 0) { for (int g2 = 0; g2 < sg; ++g2) off += SG[(dir * 8 + g2) * DK + d]; } else { for (int g2 = sg + 1; g2 < 8; ++g2) off += SG[(dir * 8 + g2) * DK + d]; }
            for (int t = 8 * sg; t < 8 * sg + 8; ++t) a[t * DK + d] += off; }
        LDS_BAR();
    }
}
template <class Cfg, bool WITH_Q> struct ChunkIn {
    static constexpr int NQ = 64 * (Cfg::DK / 8) / 512, NV = 64 * (Cfg::DV / 8) / 512;
    v4u qw[NQ], kw[NQ], vw[NV]; f32x4 bf[NQ][2], bb[NQ][2], bfl[NQ][2], bb0[NQ][2];
    __device__ __forceinline__ void load(const ChunkArgs& A, int it, int tid) {
        const int h = it & 3, n = (it >> 2) & 63, b = it >> 8, tok0 = b * SEQ + n * 64;
#pragma unroll
        for (int u = 0; u < NQ; ++u) { const int i = tid + u * 512, t = i / (Cfg::DK / 8), dc = (i % (Cfg::DK / 8)) * 8; const bf16* rp = A.proj + (size_t)(tok0 + t) * NINP + h * Cfg::DK + dc;
            if (WITH_Q) qw[u] = *(const GAS v4u*)(rp + A.qoff); kw[u] = *(const GAS v4u*)(rp + A.koff);
            if constexpr (!Cfg::SCALAR) { const GAS f32x4* pf = (const GAS f32x4*)(A.lab + (size_t)(tok0 + t) * 512 + h * Cfg::DK + dc); bf[u][0] = pf[0]; bf[u][1] = pf[1]; bb[u][0] = pf[64]; bb[u][1] = pf[65];
                if (!WITH_Q) { const GAS f32x4* pl = (const GAS f32x4*)(A.lab + (size_t)(tok0 + 63) * 512 + h * Cfg::DK + dc); const GAS f32x4* p0 = (const GAS f32x4*)(A.lab + (size_t)tok0 * 512 + 256 + h * Cfg::DK + dc);
                    bfl[u][0] = pl[0]; bfl[u][1] = pl[1]; bb0[u][0] = p0[0]; bb0[u][1] = p0[1]; } } }
#pragma unroll
        for (int u = 0; u < NV; ++u) { const int i = tid + u * 512, t = i / (Cfg::DV / 8), c = (i % (Cfg::DV / 8)) * 8; vw[u] = *(const GAS v4u*)(A.proj + (size_t)(tok0 + t) * NINP + A.voff + h * Cfg::DV + c); }
    }
};

template <class Cfg> __device__ __forceinline__ void chunk_m1_phase(Frame& F, const ChunkArgs A, const int ngemm) {
    constexpr int DK = Cfg::DK, DV = Cfg::DV, PK = Cfg::PK, PV = Cfg::PV, DT = DK / 16, ETW = DV / 128;
    typedef ChunkIn<Cfg, false> In;
    const int tid = F.wave * 64 + lane_now();
    const int lane = tid & 63, wave = __builtin_amdgcn_readfirstlane(tid >> 6), fr = lane & 15, fq = lane >> 4;
    LAS unsigned char* lds = F.lds + RING_OFF;
    In in;
    const int ibase = F.hf * (1024 / F.nt), nit = 1024 / F.nt;
    const bool bal = (ngemm * 4 == F.T && nit == 4 * F.T); const int rk = bal ? F.tr : F.tv, step = F.T;
    const int cnt = bal ? (rk < ngemm ? 1 : 5) : (rk < nit ? (nit - rk + step - 1) / step : 0);
#define M1_ITEM(k) (ibase + ((bal && (k) == 4) ? (1 + (rk - ngemm) / ngemm) * step + (rk - ngemm) % ngemm : rk + (k) * step))
    if (cnt > 0) in.load(A, M1_ITEM(0), tid);
    for (int kk = 0; kk < cnt; ++kk) { const int it = M1_ITEM(kk);
        const int h = it & 3;
        const float lg = log1pf(-exp2f(-5.0f - (float)h));
        LDS_BAR();
#pragma unroll
        for (int u = 0; u < In::NQ; ++u) { const int i = tid + u * 512, t = i / (DK / 8), dc = (i % (DK / 8)) * 8; float kf[8], o0[8], o1[8]; unpack8(in.kw[u], kf);
#pragma unroll
            for (int j = 0; j < 8; ++j) { float ef, eb;
                if constexpr (Cfg::SCALAR) { ef = (float)(63 - t) * lg; eb = (float)t * lg; } else { ef = in.bfl[u][j >> 2][j & 3] - in.bf[u][j >> 2][j & 3]; eb = in.bb0[u][j >> 2][j & 3] - in.bb[u][j >> 2][j & 3]; }
                o0[j] = kf[j] * __expf(ef); o1[j] = kf[j] * __expf(eb); }
            *(LAS v4u*)(lds + Cfg::T0 + t * PK + dc * 2) = pack8(o0); *(LAS v4u*)(lds + Cfg::T1 + t * PK + dc * 2) = pack8(o1); }
#pragma unroll
        for (int u = 0; u < In::NV; ++u) { const int i = tid + u * 512, t = i / (DV / 8), c = (i % (DV / 8)) * 8; *(LAS v4u*)(lds + Cfg::VT + t * PV + c * 2) = in.vw[u]; }
        if (tid < 2 * DK) { const int dir = tid / DK, d = tid % DK; float e;
            if constexpr (Cfg::SCALAR) e = 64.0f * lg; else { const int tok0_ = (it >> 8) * SEQ + ((it >> 2) & 63) * 64; e = A.lab[(size_t)(tok0_ + (dir == 0 ? 63 : 0)) * 512 + dir * 256 + h * DK + d]; }
            A.dec[((size_t)it * 2 + dir) * DK + d] = __expf(e); }
        if (kk + 1 < cnt) in.load(A, M1_ITEM(kk + 1), tid);
        LDS_BAR();
#pragma unroll
        for (int dir = 0; dir < 2; ++dir) {
            const LAS unsigned char* KS = lds + (dir == 0 ? Cfg::T0 : Cfg::T1);
#pragma unroll
            for (int x = 0; x < ETW; ++x) { const int et = wave * ETW + x;
                bf16x8 vf[2];
#pragma unroll
                for (int kp = 0; kp < 2; ++kp) { const LAS unsigned char* p = lds + Cfg::VT + (32 * kp + 4 * fq + (fr >> 2)) * PV + (16 * et + 4 * (fr & 3)) * 2; vf[kp] = tr_pair(p, p + 16 * PV); }
#pragma unroll
                for (int dt = 0; dt < DT; ++dt) { f32x4 acc = (f32x4){0.f, 0.f, 0.f, 0.f};
#pragma unroll
                    for (int kp = 0; kp < 2; ++kp) { const LAS unsigned char* p = KS + (32 * kp + 4 * fq + (fr >> 2)) * PK + (16 * dt + 4 * (fr & 3)) * 2; const bf16x8 kf = tr_pair(p, p + 16 * PK);
                        acc = __builtin_amdgcn_mfma_f32_16x16x32_bf16(kf, vf[kp], acc, 0, 0, 0); }
                    u32x2 w; w.x = pkh(acc[0], acc[1]); w.y = pkh(acc[2], acc[3]);
                    *(GAS u32x2*)(A.kv + (((size_t)it * 2 + dir) * DV + 16 * et + fr) * DK + 16 * dt + 4 * fq) = w; } }
        }
    }
    LDS_BAR();
}
#undef M1_ITEM
__device__ __forceinline__ void ret_scan_phase(Frame& F, const ChunkArgs A) {
    constexpr int DK = 128, DV = 256, DC = DK / 8, NCH = 32, TOTAL = 16 * 2 * DV * DC;
    const int tid = F.wave * 64 + lane_now();
    const int gt = (F.tv * NWAVES * 64) + tid, NGT = F.T * NWAVES * 64;
    for (int idx = gt; idx < TOTAL / F.nt; idx += NGT) {
        const int dch = idx % DC, e = (idx / DC) % DV, r = idx / (DC * DV), dir = r & 1, h = (r >> 1) & 3, b = F.hf * (BATCH / F.nt) + (r >> 3);
        const float lgh = h == 0 ? -0.031748698314580298f : h == 1 ? -0.015748356968139168f : h == 2 ? -0.007843177461025893f : -0.003913899321136329f; const float dec = __expf(128.0f * lgh);
        float S[8];
#pragma unroll
        for (int j = 0; j < 8; ++j) S[j] = 0.f;
        for (int s0 = 0; s0 < NCH; s0 += 16) {
            v4u kvw[16];
#pragma unroll
            for (int u = 0; u < 16; ++u) { const int n = dir == 0 ? s0 + u : NCH - 1 - s0 - u; const size_t item = (size_t)(b * NCH + n) * 4 + h; kvw[u] = *(const GAS v4u*)(A.kv + ((item * 2 + dir) * DV + e) * DK + dch * 8); }
#pragma unroll
            for (int u = 0; u < 16; ++u) { const int n = dir == 0 ? s0 + u : NCH - 1 - s0 - u; const size_t item = (size_t)(b * NCH + n) * 4 + h;
                *(GAS v4u*)(A.kv + ((item * 2 + dir) * DV + e) * DK + dch * 8) = pack8(S);
                float kf[8]; unpack8(kvw[u], kf);
#pragma unroll
                for (int j = 0; j < 8; ++j) S[j] = dec * S[j] + kf[j]; }
        }
    }
}
__device__ __forceinline__ void gla_scan_phase(Frame& F, const ChunkArgs A) {
    constexpr int DK = 64, DV = 128, DC = DK / 2, NCH = 64, TOTAL = 16 * 2 * DV * DC;
    const int tid = F.wave * 64 + lane_now();
    const int gt = (F.tv * NWAVES * 64) + tid, NGT = F.T * NWAVES * 64;
    for (int idx = gt; idx < TOTAL / F.nt; idx += NGT) {
        const int dch = idx % DC, e = (idx / DC) % DV, r = idx / (DC * DV), dir = r & 1, h = (r >> 1) & 3, b = F.hf * (BATCH / F.nt) + (r >> 3);
        float S0 = 0.f, S1 = 0.f;
        for (int s0 = 0; s0 < NCH; s0 += 16) {
            unsigned kvw[16]; f32x2 dv[16];
#pragma unroll
            for (int u = 0; u < 16; ++u) { const int n = dir == 0 ? s0 + u : NCH - 1 - s0 - u; const size_t item = (size_t)(b * NCH + n) * 4 + h;
                kvw[u] = *(const GAS unsigned*)(A.kv + ((item * 2 + dir) * DV + e) * DK + dch * 2); dv[u] = *(const GAS f32x2*)(A.dec + (item * 2 + dir) * DK + dch * 2); }
#pragma unroll
            for (int u = 0; u < 16; ++u) { const int n = dir == 0 ? s0 + u : NCH - 1 - s0 - u; const size_t item = (size_t)(b * NCH + n) * 4 + h;
                *(GAS unsigned*)(A.kv + ((item * 2 + dir) * DV + e) * DK + dch * 2) = pkh(S0, S1);
                S0 = dv[u].x * S0 + __uint_as_float(kvw[u] << 16); S1 = dv[u].y * S1 + __uint_as_float(kvw[u] & 0xffff0000u); }
        }
    }
}
template <class Cfg, bool LAYERNORM> __device__ __forceinline__ void chunk_m2_phase(Frame& F, const ChunkArgs A, const int ngemm) {
    constexpr int DK = Cfg::DK, DV = Cfg::DV, PK = Cfg::PK, PV = Cfg::PV, KS = DK / 32, EW = DV / 128, PP = 160;
    typedef ChunkIn<Cfg, true> In;
    const int tid = F.wave * 64 + lane_now();
    const int lane = tid & 63, wave = __builtin_amdgcn_readfirstlane(tid >> 6), fr = lane & 15, fq = lane >> 4;
    LAS unsigned char* lds = F.lds + RING_OFF;
    In in;
    const int ibase = F.hf * (1024 / F.nt), nit = 1024 / F.nt;
    const bool bal = (ngemm * 2 == F.T && nit == 4 * F.T); const int rk = bal ? F.tr : F.tv, step = F.T;
    const int cnt = bal ? (rk < ngemm ? 3 : 5) : (rk < nit ? (nit - rk + step - 1) / step : 0);
#define M2_ITEM(k) (ibase + ((bal && (k) == 4) ? 3 * step + (rk - ngemm) : rk + (k) * step))
    if (cnt > 0) in.load(A, M2_ITEM(0), tid);
    for (int kk = 0; kk < cnt; ++kk) { const int it = M2_ITEM(kk);
        const int h = it & 3, n = (it >> 2) & 63, b = it >> 8, tok0 = b * SEQ + n * 64;
        const float lg = log1pf(-exp2f(-5.0f - (float)h));
        bf16x8 sF[EW][KS], sB[EW][KS];
#pragma unroll
        for (int x = 0; x < EW; ++x) { const int et = wave * EW + x;
            const bf16* sfp = A.kv + (((size_t)it * 2 + 0) * DV + 16 * et + fr) * DK + 8 * fq; const bf16* sbp = A.kv + (((size_t)it * 2 + 1) * DV + 16 * et + fr) * DK + 8 * fq;
#pragma unroll
            for (int ks = 0; ks < KS; ++ks) { sF[x][ks] = *(const GAS bf16x8*)(sfp + 32 * ks); sB[x][ks] = *(const GAS bf16x8*)(sbp + 32 * ks); } }
        LDS_BAR();
#pragma unroll
        for (int u = 0; u < In::NQ; ++u) { const int i = tid + u * 512, t = i / (DK / 8), dc = (i % (DK / 8)) * 8;
            float qf[8], kf[8], o0[8], o1[8], o2[8], o3[8]; unpack8(in.qw[u], qf); unpack8(in.kw[u], kf);
#pragma unroll
            for (int j = 0; j < 8; ++j) { float bfv, bbv;
                if constexpr (Cfg::SCALAR) { bfv = (float)(t + 1) * lg; bbv = (float)(64 - t) * lg; } else { bfv = in.bf[u][j >> 2][j & 3]; bbv = in.bb[u][j >> 2][j & 3]; }
                o0[j] = qf[j] * __expf(bfv); o1[j] = qf[j] * __expf(bbv); o2[j] = kf[j] * __expf(-bfv); o3[j] = kf[j] * __expf(-bbv); }
            *(LAS v4u*)(lds + Cfg::T0 + t * PK + dc * 2) = pack8(o0); *(LAS v4u*)(lds + Cfg::T1 + t * PK + dc * 2) = pack8(o1);
            *(LAS v4u*)(lds + Cfg::T2 + t * PK + dc * 2) = pack8(o2); *(LAS v4u*)(lds + Cfg::T3 + t * PK + dc * 2) = pack8(o3); }
#pragma unroll
        for (int u = 0; u < In::NV; ++u) { const int i = tid + u * 512, t = i / (DV / 8), c = (i % (DV / 8)) * 8; *(LAS v4u*)(lds + Cfg::VT + t * PV + c * 2) = in.vw[u]; }
        if (kk + 1 < cnt) in.load(A, M2_ITEM(kk + 1), tid);
        u32x2 gw[EW][4];
#pragma unroll
        for (int itile = 0; itile < 4; ++itile)
#pragma unroll
            for (int x = 0; x < EW; ++x) gw[x][itile] = *(const GAS u32x2*)(A.proj + (size_t)(tok0 + 16 * itile + fr) * NINP + A.goff + h * DV + 16 * (wave * EW + x) + 4 * fq);
        LDS_BAR();
#pragma unroll
        for (int u = 0; u < 2; ++u) { const int pr = wave * 2 + u, jt = pr & 3, itile = pr >> 2; f32x4 sf = (f32x4){0.f, 0.f, 0.f, 0.f}, sb = (f32x4){0.f, 0.f, 0.f, 0.f};
#pragma unroll
            for (int ks = 0; ks < KS; ++ks) {
                const bf16x8 kF = *(const LAS bf16x8*)(lds + Cfg::T2 + (16 * jt + fr) * PK + (32 * ks + 8 * fq) * 2), kB = *(const LAS bf16x8*)(lds + Cfg::T3 + (16 * jt + fr) * PK + (32 * ks + 8 * fq) * 2);
                const bf16x8 qF = *(const LAS bf16x8*)(lds + Cfg::T0 + (16 * itile + fr) * PK + (32 * ks + 8 * fq) * 2), qB = *(const LAS bf16x8*)(lds + Cfg::T1 + (16 * itile + fr) * PK + (32 * ks + 8 * fq) * 2);
                sf = __builtin_amdgcn_mfma_f32_16x16x32_bf16(kF, qF, sf, 0, 0, 0); sb = __builtin_amdgcn_mfma_f32_16x16x32_bf16(kB, qB, sb, 0, 0, 0); }
            float pv[4];
#pragma unroll
            for (int ii = 0; ii < 4; ++ii) { const int j = 16 * jt + 4 * fq + ii, i = 16 * itile + fr; pv[ii] = (j <= i) ? sf[ii] : sb[ii]; }
            u32x2 w; w.x = pkh(pv[0], pv[1]); w.y = pkh(pv[2], pv[3]);
            *(LAS u32x2*)(lds + Cfg::PT + (16 * itile + fr) * PP + (32 * (jt >> 1) + 8 * fq + 4 * (jt & 1)) * 2) = w; }
        LDS_BAR();
        bf16x8 vf[EW][2];
#pragma unroll
        for (int x = 0; x < EW; ++x)
#pragma unroll
            for (int kp = 0; kp < 2; ++kp) { const LAS unsigned char* p = lds + Cfg::VT + (32 * kp + 4 * fq + (fr >> 2)) * PV + (16 * (wave * EW + x) + 4 * (fr & 3)) * 2; vf[x][kp] = tr_pair(p, p + 16 * PV); }
        f32x4 O[EW][4];
#pragma unroll
        for (int itile = 0; itile < 4; ++itile) {
#pragma unroll
            for (int x = 0; x < EW; ++x) O[x][itile] = (f32x4){0.f, 0.f, 0.f, 0.f};
#pragma unroll
            for (int kp = 0; kp < 2; ++kp) { const bf16x8 pf = *(const LAS bf16x8*)(lds + Cfg::PT + (16 * itile + fr) * PP + (32 * kp + 8 * fq) * 2);
#pragma unroll
                for (int x = 0; x < EW; ++x) O[x][itile] = __builtin_amdgcn_mfma_f32_16x16x32_bf16(vf[x][kp], pf, O[x][itile], 0, 0, 0); }
#pragma unroll
            for (int ks = 0; ks < KS; ++ks) { const bf16x8 qF = *(const LAS bf16x8*)(lds + Cfg::T0 + (16 * itile + fr) * PK + (32 * ks + 8 * fq) * 2), qB = *(const LAS bf16x8*)(lds + Cfg::T1 + (16 * itile + fr) * PK + (32 * ks + 8 * fq) * 2);
#pragma unroll
                for (int x = 0; x < EW; ++x) { O[x][itile] = __builtin_amdgcn_mfma_f32_16x16x32_bf16(sF[x][ks], qF, O[x][itile], 0, 0, 0); O[x][itile] = __builtin_amdgcn_mfma_f32_16x16x32_bf16(sB[x][ks], qB, O[x][itile], 0, 0, 0); } }
        }
        LAS f32x2* RED = (LAS f32x2*)(lds + Cfg::RED);
#pragma unroll
        for (int itile = 0; itile < 4; ++itile) { float s1 = 0.f, s2 = 0.f;
#pragma unroll
            for (int x = 0; x < EW; ++x)
#pragma unroll
                for (int ii = 0; ii < 4; ++ii) { s1 += O[x][itile][ii]; s2 += O[x][itile][ii] * O[x][itile][ii]; }
            s1 = xlane_add(s1, lane, 16); s1 = xlane_add(s1, lane, 32); s2 = xlane_add(s2, lane, 16); s2 = xlane_add(s2, lane, 32);
            if (fq == 0) RED[wave * 64 + 16 * itile + fr] = (f32x2){s1, s2}; }
        LDS_BAR();
#pragma unroll
        for (int itile = 0; itile < 4; ++itile) { float t1 = 0.f, t2 = 0.f;
#pragma unroll
            for (int w = 0; w < 8; ++w) { const f32x2 r = RED[w * 64 + 16 * itile + fr]; t1 += r.x; t2 += r.y; }
            const float m1 = t1 * (1.0f / DV), m2 = t2 * (1.0f / DV);
            const float mean = LAYERNORM ? m1 : 0.f, rstd = __builtin_amdgcn_rsqf((LAYERNORM ? m2 - m1 * m1 : m2) + EPS);
            const size_t tok = (size_t)(tok0 + 16 * itile + fr);
#pragma unroll
            for (int x = 0; x < EW; ++x) { const int e = 16 * (wave * EW + x) + 4 * fq; const u32x2 g4 = gw[x][itile];
                const float g0 = __uint_as_float(g4.x << 16), g1 = __uint_as_float(g4.x & 0xffff0000u), g2 = __uint_as_float(g4.y << 16), g3 = __uint_as_float(g4.y & 0xffff0000u);
                u32x2 w; w.x = pkh(g0 * __builtin_amdgcn_rcpf(1.0f + __expf(-g0)) * (O[x][itile][0] - mean) * rstd, g1 * __builtin_amdgcn_rcpf(1.0f + __expf(-g1)) * (O[x][itile][1] - mean) * rstd);
                w.y = pkh(g2 * __builtin_amdgcn_rcpf(1.0f + __expf(-g2)) * (O[x][itile][2] - mean) * rstd, g3 * __builtin_amdgcn_rcpf(1.0f + __expf(-g3)) * (O[x][itile][3] - mean) * rstd);
                *(GAS u32x2*)(A.Y + tok * D + A.yoff + h * DV + e) = w; } }
    }
    LDS_BAR();
}
#undef M2_ITEM
namespace r128 { constexpr int C = 128, DK = 128, DV = 256, PK = DK * 2 + 32, PV = DV * 2 + 32, T0 = 0, T1 = C * PK, VT = 2 * C * PK, RED = VT + C * PV, END = RED + 8 * 128 * 8;
    static_assert(END <= CHUNK_LDS_MAX, "retention LDS"); }
__device__ __forceinline__ float ret_lg(int h) { return h == 0 ? -0.031748698314580298f : h == 1 ? -0.015748356968139168f : h == 2 ? -0.007843177461025893f : -0.003913899321136329f; }
__device__ __forceinline__ void ret_m1_phase(Frame& F, const ChunkArgs A) {
    using namespace r128;
    const int wave = F.wave;
    LAS unsigned char* lds = F.lds + RING_OFF;
    v4u kw[4], vw[8]; bool pre = false;
    for (int it = F.hf * (512 / F.nt) + F.tv; it < (F.hf + 1) * (512 / F.nt); it += F.T) {
        const int tid = wave * 64 + lane_now(), lane = tid & 63, fr = lane & 15, fq = lane >> 4;
        const int h = it & 3, n = (it >> 2) & 31, b = it >> 7, tok0 = b * SEQ + n * C; const float lg = ret_lg(h);
        if (!pre) {
#pragma unroll
            for (int u = 0; u < 4; ++u) { const int i = tid + u * 512, t = i >> 4, dc = (i & 15) * 8; kw[u] = *(const GAS v4u*)(A.proj + (size_t)(tok0 + t) * NINP + A.koff + h * DK + dc); }
#pragma unroll
            for (int u = 0; u < 8; ++u) { const int i = tid + u * 512, t = i >> 5, c = (i & 31) * 8; vw[u] = *(const GAS v4u*)(A.proj + (size_t)(tok0 + t) * NINP + A.voff + h * DV + c); } }
        LDS_BAR();
#pragma unroll
        for (int u = 0; u < 4; ++u) { const int i = tid + u * 512, t = i >> 4, dc = (i & 15) * 8; float kf[8], o0[8], o1[8]; unpack8(kw[u], kf);
            const float sf = __expf((float)(C - 1 - t) * lg), sb = __expf((float)t * lg);
#pragma unroll
            for (int j = 0; j < 8; ++j) { o0[j] = kf[j] * sf; o1[j] = kf[j] * sb; }
            *(LAS v4u*)(lds + T0 + t * PK + dc * 2) = pack8(o0); *(LAS v4u*)(lds + T1 + t * PK + dc * 2) = pack8(o1); }
#pragma unroll
        for (int u = 0; u < 8; ++u) { const int i = tid + u * 512, t = i >> 5, c = (i & 31) * 8; *(LAS v4u*)(lds + VT + t * PV + c * 2) = vw[u]; }
        if (tid < 2 * DK) A.dec[((size_t)it * 2 + (tid >> 7)) * DK + (tid & 127)] = __expf((float)C * lg);
        pre = (it + F.T < (F.hf + 1) * (512 / F.nt));
        if (pre) { const int it2 = it + F.T, h2 = it2 & 3, tok2 = (it2 >> 7) * SEQ + ((it2 >> 2) & 31) * C;
#pragma unroll
            for (int u = 0; u < 4; ++u) { const int i = tid + u * 512, t = i >> 4, dc = (i & 15) * 8; kw[u] = *(const GAS v4u*)(A.proj + (size_t)(tok2 + t) * NINP + A.koff + h2 * DK + dc); }
#pragma unroll
            for (int u = 0; u < 8; ++u) { const int i = tid + u * 512, t = i >> 5, c = (i & 31) * 8; vw[u] = *(const GAS v4u*)(A.proj + (size_t)(tok2 + t) * NINP + A.voff + h2 * DV + c); } }
        LDS_BAR();
        bf16x8 vf[2][4];
#pragma unroll
        for (int x = 0; x < 2; ++x)
#pragma unroll
            for (int kp = 0; kp < 4; ++kp) { const LAS unsigned char* p = lds + VT + (32 * kp + 4 * fq + (fr >> 2)) * PV + (16 * (wave * 2 + x) + 4 * (fr & 3)) * 2; vf[x][kp] = tr_pair(p, p + 16 * PV); }
#pragma unroll
        for (int dir = 0; dir < 2; ++dir) { const LAS unsigned char* KS = lds + (dir == 0 ? T0 : T1);
#pragma unroll
            for (int dt = 0; dt < 8; ++dt) { f32x4 acc0 = (f32x4){0.f, 0.f, 0.f, 0.f}, acc1 = (f32x4){0.f, 0.f, 0.f, 0.f};
#pragma unroll
                for (int kp = 0; kp < 4; ++kp) { const LAS unsigned char* p = KS + (32 * kp + 4 * fq + (fr >> 2)) * PK + (16 * dt + 4 * (fr & 3)) * 2; const bf16x8 kf = tr_pair(p, p + 16 * PK);
                    acc0 = __builtin_amdgcn_mfma_f32_16x16x32_bf16(kf, vf[0][kp], acc0, 0, 0, 0); acc1 = __builtin_amdgcn_mfma_f32_16x16x32_bf16(kf, vf[1][kp], acc1, 0, 0, 0); }
                u32x2 w0; w0.x = pkh(acc0[0], acc0[1]); w0.y = pkh(acc0[2], acc0[3]); u32x2 w1; w1.x = pkh(acc1[0], acc1[1]); w1.y = pkh(acc1[2], acc1[3]);
                *(GAS u32x2*)(A.kv + (((size_t)it * 2 + dir) * DV + 16 * (wave * 2 + 0) + fr) * DK + 16 * dt + 4 * fq) = w0;
                *(GAS u32x2*)(A.kv + (((size_t)it * 2 + dir) * DV + 16 * (wave * 2 + 1) + fr) * DK + 16 * dt + 4 * fq) = w1; } }
    }
    LDS_BAR();
}
__device__ __forceinline__ void ret_m2_phase(Frame& F, const ChunkArgs A) {
    using namespace r128;
    const int wave = F.wave;
    LAS unsigned char* lds = F.lds + RING_OFF;
    for (int it = F.hf * (512 / F.nt) + F.tv; it < (F.hf + 1) * (512 / F.nt); it += F.T) {
        const int tid = wave * 64 + lane_now(), lane = tid & 63, fr = lane & 15, fq = lane >> 4;
        const int h = it & 3, n = (it >> 2) & 31, b = it >> 7, tok0 = b * SEQ + n * C; const float lg = ret_lg(h), l2g = lg * 1.4426950408889634f;
        { v4u qw[4], kw[4], vw[8];
#pragma unroll
          for (int u = 0; u < 4; ++u) { const int i = tid + u * 512, t = i >> 4, dc = (i & 15) * 8; const bf16* rp = A.proj + (size_t)(tok0 + t) * NINP + h * DK + dc; qw[u] = *(const GAS v4u*)(rp + A.qoff); kw[u] = *(const GAS v4u*)(rp + A.koff); }
#pragma unroll
          for (int u = 0; u < 8; ++u) { const int i = tid + u * 512, t = i >> 5, c = (i & 31) * 8; vw[u] = *(const GAS v4u*)(A.proj + (size_t)(tok0 + t) * NINP + A.voff + h * DV + c); }
          LDS_BAR();
#pragma unroll
          for (int u = 0; u < 4; ++u) { const int i = tid + u * 512, t = i >> 4, dc = (i & 15) * 8; *(LAS v4u*)(lds + T0 + t * PK + dc * 2) = qw[u]; *(LAS v4u*)(lds + T1 + t * PK + dc * 2) = kw[u]; }
#pragma unroll
          for (int u = 0; u < 8; ++u) { const int i = tid + u * 512, t = i >> 5, c = (i & 31) * 8; *(LAS v4u*)(lds + VT + t * PV + c * 2) = vw[u]; } }
        LDS_BAR();
        u32x2 pw[8];
        { bf16x8 qf[4];
#pragma unroll
          for (int ks = 0; ks < 4; ++ks) qf[ks] = *(const LAS bf16x8*)(lds + T0 + (16 * wave + fr) * PK + (32 * ks + 8 * fq) * 2);
#pragma unroll
          for (int jt = 0; jt < 8; ++jt) { f32x4 st = (f32x4){0.f, 0.f, 0.f, 0.f};
#pragma unroll
              for (int ks = 0; ks < 4; ++ks) { const bf16x8 kf = *(const LAS bf16x8*)(lds + T1 + (16 * jt + fr) * PK + (32 * ks + 8 * fq) * 2); st = __builtin_amdgcn_mfma_f32_16x16x32_bf16(kf, qf[ks], st, 0, 0, 0); }
              float pv[4];
#pragma unroll
              for (int ii = 0; ii < 4; ++ii) { const int dj = 16 * jt + 4 * fq + ii - (16 * wave + fr); pv[ii] = st[ii] * __builtin_amdgcn_exp2f((float)(dj < 0 ? -dj : dj) * l2g); }
              pw[jt].x = pkh(pv[0], pv[1]); pw[jt].y = pkh(pv[2], pv[3]); } }
        bf16x8 sF[2][4], sB[2][4];
#pragma unroll
        for (int x = 0; x < 2; ++x) { const int et = wave * 2 + x;
            const bf16* sfp = A.kv + (((size_t)it * 2 + 0) * DV + 16 * et + fr) * DK + 8 * fq; const bf16* sbp = A.kv + (((size_t)it * 2 + 1) * DV + 16 * et + fr) * DK + 8 * fq;
#pragma unroll
            for (int ks = 0; ks < 4; ++ks) { sF[x][ks] = *(const GAS bf16x8*)(sfp + 32 * ks); sB[x][ks] = *(const GAS bf16x8*)(sbp + 32 * ks); } }
        LDS_BAR();
#pragma unroll
        for (int jt = 0; jt < 8; ++jt) *(LAS u32x2*)(lds + T1 + (16 * wave + fr) * PK + (32 * (jt >> 1) + 8 * fq + 4 * (jt & 1)) * 2) = pw[jt];
        LDS_BAR();
        f32x4 O[2][8];
        { bf16x8 vf[2][4];
#pragma unroll
          for (int x = 0; x < 2; ++x)
#pragma unroll
            for (int kp = 0; kp < 4; ++kp) { const LAS unsigned char* p = lds + VT + (32 * kp + 4 * fq + (fr >> 2)) * PV + (16 * (wave * 2 + x) + 4 * (fr & 3)) * 2; vf[x][kp] = tr_pair(p, p + 16 * PV); }
#pragma unroll
          for (int itile = 0; itile < 8; ++itile) {
#pragma unroll
            for (int x = 0; x < 2; ++x) O[x][itile] = (f32x4){0.f, 0.f, 0.f, 0.f};
#pragma unroll
            for (int kp = 0; kp < 4; ++kp) { const bf16x8 pf = *(const LAS bf16x8*)(lds + T1 + (16 * itile + fr) * PK + (32 * kp + 8 * fq) * 2);
#pragma unroll
                for (int x = 0; x < 2; ++x) O[x][itile] = __builtin_amdgcn_mfma_f32_16x16x32_bf16(vf[x][kp], pf, O[x][itile], 0, 0, 0); }
            asm volatile("" ::: "memory"); } }
#pragma unroll
        for (int itile = 0; itile < 8; ++itile) { f32x4 Tf[2], Tb[2];
#pragma unroll
            for (int x = 0; x < 2; ++x) { Tf[x] = (f32x4){0.f, 0.f, 0.f, 0.f}; Tb[x] = (f32x4){0.f, 0.f, 0.f, 0.f}; }
#pragma unroll
            for (int ks = 0; ks < 4; ++ks) { const bf16x8 qf = *(const LAS bf16x8*)(lds + T0 + (16 * itile + fr) * PK + (32 * ks + 8 * fq) * 2);
#pragma unroll
                for (int x = 0; x < 2; ++x) { Tf[x] = __builtin_amdgcn_mfma_f32_16x16x32_bf16(sF[x][ks], qf, Tf[x], 0, 0, 0); Tb[x] = __builtin_amdgcn_mfma_f32_16x16x32_bf16(sB[x][ks], qf, Tb[x], 0, 0, 0); } }
            const int i = 16 * itile + fr; const float cf = __builtin_amdgcn_exp2f((float)(i + 1) * l2g), cb = __builtin_amdgcn_exp2f((float)(C - i) * l2g);
#pragma unroll
            for (int x = 0; x < 2; ++x) O[x][itile] = O[x][itile] + Tf[x] * cf + Tb[x] * cb;
            asm volatile("" ::: "memory"); }
        u32x2 gq[2][8];
#pragma unroll
        for (int itile = 0; itile < 8; ++itile)
#pragma unroll
            for (int x = 0; x < 2; ++x) gq[x][itile] = *(const GAS u32x2*)(A.proj + (size_t)(tok0 + 16 * itile + fr) * NINP + A.goff + h * DV + 16 * (wave * 2 + x) + 4 * fq);
        LAS f32x2* REDp = (LAS f32x2*)(lds + RED);
#pragma unroll
        for (int itile = 0; itile < 8; ++itile) { float s1 = 0.f, s2 = 0.f;
#pragma unroll
            for (int x = 0; x < 2; ++x)
#pragma unroll
                for (int ii = 0; ii < 4; ++ii) { s1 += O[x][itile][ii]; s2 += O[x][itile][ii] * O[x][itile][ii]; }
            s1 = xlane_add(s1, lane, 16); s1 = xlane_add(s1, lane, 32); s2 = xlane_add(s2, lane, 16); s2 = xlane_add(s2, lane, 32);
            if (fq == 0) REDp[wave * 128 + 16 * itile + fr] = (f32x2){s1, s2}; }
        LDS_BAR();
#pragma unroll
        for (int itile = 0; itile < 8; ++itile) { float t1 = 0.f, t2 = 0.f;
#pragma unroll
            for (int w = 0; w < 8; ++w) { const f32x2 r = REDp[w * 128 + 16 * itile + fr]; t1 += r.x; t2 += r.y; }
            const float mean = t1 * (1.0f / DV), rstd = __builtin_amdgcn_rsqf(t2 * (1.0f / DV) - mean * mean + EPS);
            const size_t tok = (size_t)(tok0 + 16 * itile + fr);
#pragma unroll
            for (int x = 0; x < 2; ++x) { const int e = 16 * (wave * 2 + x) + 4 * fq; const u32x2 g4 = gq[x][itile];
                const float g0 = __uint_as_float(g4.x << 16), g1 = __uint_as_float(g4.x & 0xffff0000u), g2 = __uint_as_float(g4.y << 16), g3 = __uint_as_float(g4.y & 0xffff0000u);
                u32x2 w; w.x = pkh(g0 * __builtin_amdgcn_rcpf(1.0f + __expf(-g0)) * (O[x][itile][0] - mean) * rstd, g1 * __builtin_amdgcn_rcpf(1.0f + __expf(-g1)) * (O[x][itile][1] - mean) * rstd);
                w.y = pkh(g2 * __builtin_amdgcn_rcpf(1.0f + __expf(-g2)) * (O[x][itile][2] - mean) * rstd, g3 * __builtin_amdgcn_rcpf(1.0f + __expf(-g3)) * (O[x][itile][3] - mean) * rstd);
                *(GAS u32x2*)(A.Y + tok * D + A.yoff + h * DV + e) = w; }
            asm volatile("" ::: "memory"); }
    }
    LDS_BAR();
}
typedef ChunkCfg<128, 256, true> RetCfg;
typedef ChunkCfg<64, 128, false> GlaCfg;

__device__ __forceinline__ void lr_phase(Frame& F, const bf16* U, const bf16* Bt, const float* wg, const float* bg, float* lab) {
    const int tid = F.wave * 64 + lane_now();
    const int lane = tid & 63, wave = __builtin_amdgcn_readfirstlane(tid >> 6), fr = lane & 15, fq = lane >> 4;
    LAS f32x4* RED = (LAS f32x4*)(F.lds + RING_OFF);
    LAS float* LRs = (LAS float*)(F.lds + RING_OFF + 65536);
    for (int it = F.hf * (M / 64 / F.nt) + F.tv; it < (F.hf + 1) * (M / 64 / F.nt); it += F.T) {
        const int row0 = it * 64;
        const int c = tid & 255, dir = tid >> 8; float wgr[16];
#pragma unroll
        for (int r = 0; r < 16; ++r) wgr[r] = wg[(dir * 16 + r) * 256 + c];
        const float bgv = bg[dir * 256 + c];
        f32x4 acc[4][2];
#pragma unroll
        for (int mt = 0; mt < 4; ++mt) { acc[mt][0] = (f32x4){0.f, 0.f, 0.f, 0.f}; acc[mt][1] = (f32x4){0.f, 0.f, 0.f, 0.f}; }
#pragma unroll
        for (int ks = 0; ks < 8; ++ks) { const int k = 256 * wave + 32 * ks + 8 * fq;
            const bf16x8 b0 = *(const GAS bf16x8*)(Bt + (size_t)fr * D + k), b1 = *(const GAS bf16x8*)(Bt + (size_t)(16 + fr) * D + k);
#pragma unroll
            for (int mt = 0; mt < 4; ++mt) { const bf16x8 a = *(const GAS bf16x8*)(U + (size_t)(row0 + 16 * mt + fr) * D + k);
                acc[mt][0] = __builtin_amdgcn_mfma_f32_16x16x32_bf16(a, b0, acc[mt][0], 0, 0, 0); acc[mt][1] = __builtin_amdgcn_mfma_f32_16x16x32_bf16(a, b1, acc[mt][1], 0, 0, 0); } }
#pragma unroll
        for (int mt = 0; mt < 4; ++mt) { RED[(wave * 8 + mt * 2 + 0) * 64 + lane] = acc[mt][0]; RED[(wave * 8 + mt * 2 + 1) * 64 + lane] = acc[mt][1]; }
        LDS_BAR();
        { const int tile = tid >> 6, l = tid & 63, mt = tile >> 1, nt = tile & 1; f32x4 s = RED[tile * 64 + l];
#pragma unroll
          for (int w = 1; w < 8; ++w) s += RED[(w * 8 + tile) * 64 + l];
#pragma unroll
          for (int ii = 0; ii < 4; ++ii) LRs[(16 * mt + 4 * (l >> 4) + ii) * 32 + 16 * nt + (l & 15)] = s[ii]; }
        LDS_BAR();
        { float run = 0.f;
          for (int tt0 = 0; tt0 < 64; tt0 += 8) { float la[8];
#pragma unroll
              for (int u = 0; u < 8; ++u) { const int t = dir == 0 ? tt0 + u : 63 - tt0 - u; float s0 = bgv, s1 = 0.f;
#pragma unroll
                  for (int r = 0; r < 16; r += 4) { const f32x4 lr4 = *(const LAS f32x4*)(LRs + t * 32 + dir * 16 + r); s0 += lr4[0] * wgr[r] + lr4[1] * wgr[r + 1]; s1 += lr4[2] * wgr[r + 2] + lr4[3] * wgr[r + 3]; }
                  const float sv = s0 + s1; la[u] = (fminf(sv, 0.f) - __logf(1.0f + __expf(-fabsf(sv)))) * (1.0f / 16.0f); }
#pragma unroll
              for (int u = 0; u < 8; ++u) { const int t = dir == 0 ? tt0 + u : 63 - tt0 - u; run += la[u]; lab[(size_t)(row0 + t) * 512 + dir * 256 + c] = run; } } }
        LDS_BAR();
    }
}
constexpr int NP = 13;
constexpr int PH_FINAL = 1 + DEPTH * NP;
constexpr int PH_END = PH_FINAL + 1;

#define MK_BAR(b, k) XcdBarrier b; b.bar = (unsigned*)WSP(WS_CTL) + CW_BAR + (kargs()->li * 12 + (k)) * XCD_BAR_WORDS; b.x = xb_xcc_id(); b.w0 = (F.wave == 0); b.expect = (unsigned)((k) == 0 ? F.G : (k) >= 10 ? F.G / 2 : (k) >= 2 ? F.G / 8 : F.T); b.st = (volatile LAS unsigned*)((LAS unsigned char*)lds + MISC_OFF) + 8 + 2 * ((k) == 0 ? 0 : (k) >= 10 ? 2 : 1)
#define MIXER_BLOCK(l, pb) \
        if (IN(pb + 5)) { \
            pg8::Gemm g = pg8::mk_gemm((const bf16*)WSP(WS_SUA), (const bf16*)WSP(WS_W1) + (size_t)l * S5_G * 256 * 512, 512, 256, 512); g.lda = 768; g.sA = (size_t)512 * 768; g.sB = (size_t)256 * 512; \
            pg8::BatchOrder S; S.init(512 / F.nt, 256, S5_G, F.T, F.tr); S.pm0 = F.hf * (512 / F.nt / 256); pg8::EpiS5State E{(float*)WSP(WS_SC)}; \
            pg8::gemm_phase<pg8::EpiS5State, pg8::BatchOrder, true, true>(F.lds + RING_OFF, g, S, E, F.wave); \
            if (FAST_MASK & 2) ret_m1_phase(F, RET_ARGS(l)); \
            if (FAST_MASK & 1) chunk_m1_phase<GlaCfg>(F, GLA_ARGS(l), 64 / F.nt); \
            if (PROBE_DUP & 4) { ret_m1_phase(F, RET_ARGS(l)); chunk_m1_phase<GlaCfg>(F, GLA_ARGS(l), 64 / F.nt); } \
            if (PROBE_DUP & 16) { pg8::gemm_phase<pg8::EpiS5State, pg8::BatchOrder, true, true>(F.lds + RING_OFF, g, S, E, F.wave); } \
            if (BOTH(pb + 5)) MIX_BAR(); } \
        if (IN(pb + 6)) { s5_scan_phase(F, l); \
            if (FAST_MASK & 2) ret_scan_phase(F, RET_ARGS(l)); \
            if (FAST_MASK & 1) gla_scan_phase(F, GLA_ARGS(l)); \
            if (BOTH(pb + 6)) MIX_BAR(); } \
        if (IN(pb + 7)) { \
            pg8::Gemm g = pg8::mk_gemm((const bf16*)WSP(WS_SUA), (const bf16*)WSP(WS_MF) + (size_t)l * S5_G * 512 * 768, 512, 512, 768); g.sA = (size_t)512 * 768; g.sB = (size_t)512 * 768; \
            pg8::BatchOrder S; S.init(512 / F.nt, 512, S5_G, F.T, F.tr); S.pm0 = F.hf * (512 / F.nt / 256); pg8::EpiS5Out E{ZP}; \
            pg8::gemm_phase<pg8::EpiS5Out, pg8::BatchOrder, true, true>(F.lds + RING_OFF, g, S, E, F.wave); \
            if (FAST_MASK & 2) ret_m2_phase(F, RET_ARGS(l)); \
            if (FAST_MASK & 1) chunk_m2_phase<GlaCfg, false>(F, GLA_ARGS(l), 128 / F.nt); \
            if (PROBE_DUP & 8) { ret_m2_phase(F, RET_ARGS(l)); chunk_m2_phase<GlaCfg, false>(F, GLA_ARGS(l), 128 / F.nt); } \
            if (PROBE_DUP & 16) { pg8::gemm_phase<pg8::EpiS5Out, pg8::BatchOrder, true, true>(F.lds + RING_OFF, g, S, E, F.wave); } \
            if (BOTH(pb + 7)) MIX_BAR(); }
__global__ void __launch_bounds__(NWAVES * 64, 2) mega(Args args_unused) {
    extern __shared__ __attribute__((aligned(16))) unsigned char lds[];
    Frame F;
    F.lds = (LAS unsigned char*)lds;
    F.MISC = (volatile LAS unsigned*)(F.lds + MISC_OFF);
    F.tid = threadIdx.x; F.lane = F.tid & 63; F.wave = __builtin_amdgcn_readfirstlane(F.tid >> 6);
    F.G = gridDim.x; { const int bx = blockIdx.x; F.vcu = (F.G % 8 == 0) ? (bx % 8) * (F.G / 8) + bx / 8 : bx; }
    { const int bx = blockIdx.x; const bool split = (F.G == 256) && TEAM_SPLIT;
      F.nt = split ? 2 : 1; F.hf = split ? ((bx & 7) >> 2) : 0; F.T = F.G / F.nt; F.tr = split ? (bx >> 3) * 4 + (bx & 3) : bx; F.tv = split ? (bx & 3) * (F.T / 4) + (bx >> 3) : F.vcu; }
    F.ctl = nullptr;
    for (int u = F.tid; u < (LDS_BYTES - LDSCTL_OFF) / 4; u += NWAVES * 64) ((LAS unsigned*)(F.lds + LDSCTL_OFF))[u] = 0u;
    __syncthreads();
    const int lo = kargs()->ph_lo, hi = kargs()->ph_hi;
    const bool lb = LOCAL_BARS && !TEAM_SPLIT && F.G == 256;
    if (hi - lo > 1) { (void)xcd_barrier_post((unsigned*)WSP(WS_CTL) + CW_BAR + (kargs()->li * 12 + 0) * XCD_BAR_WORDS, F.MISC + 8);
                       (void)xcd_barrier_post((unsigned*)WSP(WS_CTL) + CW_BAR + (kargs()->li * 12 + (lb ? 2 + (int)(blockIdx.x & 7) : 1 + F.hf)) * XCD_BAR_WORDS, F.MISC + 10);
                       if (lb) (void)xcd_barrier_post((unsigned*)WSP(WS_CTL) + CW_BAR + (kargs()->li * 12 + 10 + (int)((blockIdx.x & 7) >> 2)) * XCD_BAR_WORDS, F.MISC + 12); }
#define GRID_BAR() do { if (TEAM_SPLIT) { MK_BAR(bar_, 1 + F.hf); xcd_barrier(bar_); } else { MK_BAR(bar_, 0); xcd_barrier(bar_); } } while (0)
#define LOCAL_BAR() do { if (lb) { MK_BAR(bar_, 2 + (int)(blockIdx.x & 7)); xcd_barrier(bar_); } else GRID_BAR(); } while (0)
#define WHOLE_BAR() do { MK_BAR(bar_, 0); xcd_barrier(bar_); } while (0)
#define MIX_BAR() do { if (lb) { MK_BAR(bar_, 10 + (int)((blockIdx.x & 7) >> 2)); xcd_barrier(bar_); } else GRID_BAR(); } while (0)
#define STAGGER() do { if (STAGGER_TICKS > 0) { const unsigned long long t0_ = __builtin_amdgcn_s_memrealtime(), d_ = (unsigned long long)(STAGGER_XCD ? (blockIdx.x & 7) : ((blockIdx.x >> 3) & 31)) * STAGGER_TICKS; while (__builtin_amdgcn_s_memrealtime() - t0_ < d_) __builtin_amdgcn_s_sleep(1); } } while (0)
#define IN(k) (lo <= (k) && (k) < hi)
#define BOTH(k) (IN(k) && IN((k) + 1))
#define LW(l, off) ((const bf16*)(WSP(WS_W) + (size_t)(l) * LW_STRIDE + (off)))
#define MODP(l, k) ((const float*)WSP(WS_MOD) + (size_t)(l) * BATCH * MODW + (k) * D)
#define HP ((h16*)WSP(WS_H))
#define UP ((bf16*)WSP(WS_U))
#define YP ((bf16*)WSP(WS_Y))
#define ZP ((bf16*)WSP(WS_Z))
#define GP ((bf16*)WSP(WS_G2))
#define W2P(l, s) ((const bf16*)WSP(WS_W2P) + (size_t)((l) * 2 + (s)) * D * LDG)
#define PROJP ((bf16*)WSP(WS_PROJ))
#define RET_ARGS(l) (ChunkArgs{PROJP, PC_RQ, PC_RK, PC_RV, PC_RG, (bf16*)WSP(WS_KV_R), (float*)WSP(WS_DEC_R), YP, 0, nullptr, nullptr, nullptr})
#define GLA_ARGS(l) (ChunkArgs{PROJP, PC_GQ, PC_GK, PC_GV, PC_GR, (bf16*)WSP(WS_KV_G), (float*)WSP(WS_DEC_G), YP, 1536, INP(I_WGATE) + (size_t)(l) * 2 * 16 * 256, INP(I_BGATE) + (size_t)(l) * 2 * 256, (const float*)WSP(WS_LA)})

    if (IN(0)) { p0_prologue(F);
#if PROBE_DUP & 1
        WHOLE_BAR(); p0_prologue(F);
#endif
        if (BOTH(0)) { WHOLE_BAR();
            if (F.hf == 1) { const unsigned long long t0 = __builtin_amdgcn_s_memrealtime(); while (__builtin_amdgcn_s_memrealtime() - t0 < 4000ull) __builtin_amdgcn_s_sleep(8); } } }

#pragma clang loop unroll(disable)
    for (int l = 0; l < DEPTH; ++l) {
        const int pb = 1 + l * NP;
        if (pb + NP <= lo || pb >= hi) continue;
        if (IN(pb + 0)) { if (l == 0) norm_mod_phase<false>(F, INP(I_X), INP(I_GFFN1), MODP(0, 0), MODP(0, 1), UP, HP); else norm_mod_phase<true>(F, HP, INP(I_GFFN1) + (size_t)l * D, MODP(l, 0), MODP(l, 1), UP, nullptr); if (BOTH(pb + 0)) LOCAL_BAR(); }
        if (IN(pb + 1)) { STAGGER(); const pg8::Gemm g = pg8::mk_gemm(UP, LW(l, LW_13A), M, 2 * FF, D); pg8::StaticOrder S; S.init(M / F.nt, 2 * FF, F.T, F.tr); S.pm0 = F.hf * (M / F.nt / 256); pg8::EpiSwiGLU E{GP, LDG};
            pg8::gemm_phase<pg8::EpiSwiGLU, pg8::StaticOrder, true, true>(F.lds + RING_OFF, g, S, E, F.wave); if (BOTH(pb + 1)) LOCAL_BAR(); }
        if (IN(pb + 2)) { pg8::Gemm g = pg8::mk_gemm(GP, W2P(l, 0), M, D, FF); g.lda = LDG; g.ldb = LDG; pg8::StaticOrder S; S.init(M / F.nt, D, F.T, F.tr); S.pm0 = F.hf * (M / F.nt / 256); S.alt = (F.T * F.nt == 256); pg8::EpiResid E{HP, HP, D, MODP(l, 2), MODW, 0.5f};
            pg8::gemm_phase<pg8::EpiResid, pg8::StaticOrder, true, true>(F.lds + RING_OFF, g, S, E, F.wave); if (BOTH(pb + 2)) LOCAL_BAR(); }
        if (IN(pb + 3)) { norm_mod_phase<true>(F, HP, INP(I_GMIX) + (size_t)l * D, MODP(l, 3), MODP(l, 4), UP, nullptr); if (BOTH(pb + 3)) LOCAL_BAR(); }
        if (IN(pb + 4)) { const pg8::Gemm g = pg8::mk_gemm(UP, LW(l, LW_IN), M, 5120, D); pg8::StaticOrder S; S.init(M / F.nt, 5120, F.T, F.tr); S.pm0 = F.hf * (M / F.nt / 256); pg8::EpiProj E{PROJP, NINP, (const float*)WSP(WS_ROT), (const float*)WSP(WS_ROT) + SEQ * 64, (bf16*)WSP(WS_SUA)};
            pg8::gemm_phase<pg8::EpiProj, pg8::StaticOrder, true, true>(F.lds + RING_OFF, g, S, E, F.wave);
            lr_phase(F, UP, LW(l, LW_IN) + (size_t)PC_LR * D, INP(I_WGATE) + (size_t)l * 2 * 16 * 256, INP(I_BGATE) + (size_t)l * 2 * 256, (float*)WSP(WS_LA)); if (BOTH(pb + 4)) MIX_BAR(); }
        if (lb) { const int bx = blockIdx.x; F.nt = 2; F.hf = (bx & 7) >> 2; F.T = F.G / 2; F.tr = (bx >> 3) * 4 + (bx & 3); F.tv = (bx & 3) * (F.T / 4) + (bx >> 3); }
        MIXER_BLOCK(l, pb)
        if (lb) { F.nt = 1; F.hf = 0; F.T = F.G; F.tr = (int)blockIdx.x; F.tv = F.vcu; }
#if PROBE_DUP & 2
        GRID_BAR(); MIXER_BLOCK(l, pb)
#endif
        if (IN(pb + 8)) { const pg8::Gemm g = pg8::mk_gemm(ZP, LW(l, LW_GLU), M, S5_W, S5_W); pg8::StaticOrder S; S.init(M / F.nt, S5_W, F.T, F.tr); S.pm0 = F.hf * (M / F.nt / 256); pg8::EpiGlu E{ZP, S5_W, YP, D, 1024, INP(I_BGLU) + (size_t)l * S5_W};
            pg8::gemm_phase<pg8::EpiGlu, pg8::StaticOrder, true, true>(F.lds + RING_OFF, g, S, E, F.wave); if (BOTH(pb + 8)) LOCAL_BAR(); }
        if (IN(pb + 9)) { const pg8::Gemm g = pg8::mk_gemm(YP, LW(l, LW_OUT), M, D, D); pg8::StaticOrder S; S.init(M / F.nt, D, F.T, F.tr); S.pm0 = F.hf * (M / F.nt / 256); S.alt = (F.T * F.nt == 256); pg8::EpiResid E{HP, HP, D, MODP(l, 5), MODW, 1.0f};
            pg8::gemm_phase<pg8::EpiResid, pg8::StaticOrder, true, true>(F.lds + RING_OFF, g, S, E, F.wave); if (BOTH(pb + 9)) LOCAL_BAR(); }
        if (IN(pb + 10)) { norm_mod_phase<true>(F, HP, INP(I_GFFN2) + (size_t)l * D, MODP(l, 6), MODP(l, 7), UP, nullptr); if (BOTH(pb + 10)) LOCAL_BAR(); }
        if (IN(pb + 11)) { STAGGER(); const pg8::Gemm g = pg8::mk_gemm(UP, LW(l, LW_13B), M, 2 * FF, D); pg8::StaticOrder S; S.init(M / F.nt, 2 * FF, F.T, F.tr); S.pm0 = F.hf * (M / F.nt / 256); pg8::EpiSwiGLU E{GP, LDG};
            pg8::gemm_phase<pg8::EpiSwiGLU, pg8::StaticOrder, true, true>(F.lds + RING_OFF, g, S, E, F.wave); if (BOTH(pb + 11)) LOCAL_BAR(); }
        if (IN(pb + 12)) { pg8::Gemm g = pg8::mk_gemm(GP, W2P(l, 1), M, D, FF); g.lda = LDG; g.ldb = LDG; pg8::StaticOrder S; S.init(M / F.nt, D, F.T, F.tr); S.pm0 = F.hf * (M / F.nt / 256); S.alt = (F.T * F.nt == 256); pg8::EpiResid E{HP, HP, D, MODP(l, 8), MODW, 0.5f};
            pg8::gemm_phase<pg8::EpiResid, pg8::StaticOrder, true, true>(F.lds + RING_OFF, g, S, E, F.wave); if (BOTH(pb + 12)) LOCAL_BAR(); }
    }
    if (IN(PH_FINAL)) final_norm_phase(F, HP, INP(I_GFINAL), kargs()->out);
#undef IN
#undef BOTH
#undef GRID_BAR
}

__global__ void __launch_bounds__(512) naive_la(const bf16* proj, const float* wg, const float* bg, float* la) {
    const int m = blockIdx.x, dir = threadIdx.x >> 8, c = threadIdx.x & 255;
    float s = bg[dir * 256 + c];
#pragma unroll
    for (int r = 0; r < GLA_R; ++r) s += bf2f(proj[(size_t)m * NINP + PC_LR + dir * 16 + r]) * wg[(dir * 16 + r) * 256 + c];
    la[((size_t)m * 2 + dir) * 256 + c] = (fminf(s, 0.f) - log1pf(expf(-fabsf(s)))) * (1.0f / 16.0f);
}
template <int DK, int DV, int MODE>
__global__ void __launch_bounds__(256) naive_linrec(const bf16* proj, const float* la, float* o, int dir) {
    constexpr int ES = 32, NE = DV / ES, DPT = DK / 8, TB = 16, NH = 4, OW = NH * DV;
    const int bid = blockIdx.x, es = bid % NE, h = (bid / NE) % NH, b = bid / (NE * NH);
    const int tid = threadIdx.x, e = tid & 31, dg = tid >> 5;
    __shared__ float q_s[TB][DK], k_s[TB][DK], a_s[TB][DK], v_s[TB][ES], red[TB][8][ES];
    constexpr int qoff = MODE == 0 ? PC_RQ : PC_GQ, koff = MODE == 0 ? PC_RK : PC_GK, voff = MODE == 0 ? PC_RV : PC_GV;
    const float gamma = 1.0f - exp2f(-5.0f - (float)h);
    const float scale = MODE == 0 ? 0.08838834764831845f : 0.125f;
    float S[DPT];
#pragma unroll
    for (int i = 0; i < DPT; ++i) S[i] = 0.f;
    for (int bi = 0; bi < SEQ / TB; ++bi) {
        const int t0 = dir == 0 ? bi * TB : SEQ - TB - bi * TB;
        for (int idx = tid; idx < TB * DK; idx += 256) { const int s = idx / DK, d = idx % DK, t = t0 + s; const size_t row = (size_t)(b * SEQ + t);
            q_s[s][d] = bf2f(proj[row * NINP + qoff + h * DK + d]); k_s[s][d] = bf2f(proj[row * NINP + koff + h * DK + d]);
            if (MODE == 1) a_s[s][d] = expf(la[(row * 2 + dir) * 256 + h * DK + d]); }
        for (int idx = tid; idx < TB * ES; idx += 256) { const int s = idx >> 5, ee = idx & 31; v_s[s][ee] = bf2f(proj[(size_t)(b * SEQ + t0 + s) * NINP + voff + h * DV + es * ES + ee]); }
        __syncthreads();
        for (int ss = 0; ss < TB; ++ss) { const int s = dir == 0 ? ss : TB - 1 - ss;
            const float v = v_s[s][e]; float acc = 0.f;
#pragma unroll
            for (int i = 0; i < DPT; ++i) { const int d = dg * DPT + i; const float a = MODE == 0 ? gamma : a_s[s][d];
                const float dec = a * S[i], sn = dec + k_s[s][d] * v; acc += q_s[s][d] * (dir == 0 ? sn : dec); S[i] = sn; }
            red[s][dg][e] = acc; }
        __syncthreads();
        for (int idx = tid; idx < TB * ES; idx += 256) { const int s = idx >> 5, ee = idx & 31; float sum = 0.f;
#pragma unroll
            for (int w = 0; w < 8; ++w) sum += red[s][w][ee];
            float* op = o + (size_t)(b * SEQ + t0 + s) * OW + h * DV + es * ES + ee; if (dir == 0) *op = sum; else *op += sum; }
    }
}
__device__ __forceinline__ float gelu_tanh(float x) { const float u = 0.7978845608028654f * (x + 0.044715f * x * x * x); return 0.5f * x * (1.0f + tanhf(u)); }
__global__ void __launch_bounds__(64) naive_s5(const bf16* proj, const float* lamb, const float* bbar, const float* cre, const float* cim, const float* dsk, float* ys5, bf16* Z) {
    const int g = blockIdx.x % S5_G, b = blockIdx.x / S5_G, p = threadIdx.x;
    __shared__ float u_s[64][16]; __shared__ float part[16][65];
    for (int dir = 0; dir < 2; ++dir) {
        const int gi = (dir * S5_G + g) * S5_P + p;
        const float lr = lamb[2 * gi], li = lamb[2 * gi + 1];
        float Br[16], Bi[16], Cr[16], Ci[16];
#pragma unroll
        for (int c = 0; c < 16; ++c) { Br[c] = bbar[((size_t)gi * 16 + c) * 2]; Bi[c] = bbar[((size_t)gi * 16 + c) * 2 + 1];
            Cr[c] = cre[((size_t)(dir * S5_G + g) * 16 + c) * S5_P + p]; Ci[c] = cim[((size_t)(dir * S5_G + g) * 16 + c) * S5_P + p]; }
        float xr = 0.f, xi = 0.f;
        for (int bi = 0; bi < SEQ / 64; ++bi) {
            const int t0 = dir == 0 ? bi * 64 : SEQ - 64 - bi * 64;
            { const size_t row = (size_t)(b * SEQ + t0 + p) * NINP + PC_SU + g * 16;
#pragma unroll
              for (int c = 0; c < 16; ++c) u_s[p][c] = bf2f(proj[row + c]); }
            __syncthreads();
            for (int ss = 0; ss < 64; ++ss) { const int s = dir == 0 ? ss : 63 - ss;
                float bur = 0.f, bui = 0.f;
#pragma unroll
                for (int c = 0; c < 16; ++c) { const float uv = u_s[s][c]; bur += Br[c] * uv; bui += Bi[c] * uv; }
                const float nr = lr * xr - li * xi + bur, ni = lr * xi + li * xr + bui; xr = nr; xi = ni;
#pragma unroll
                for (int c = 0; c < 16; ++c) part[c][p] = Cr[c] * xr - Ci[c] * xi;
                __syncthreads();
                const int c = p >> 2, q = p & 3; float sm = 0.f;
#pragma unroll
                for (int i = 0; i < 16; ++i) sm += part[c][q * 16 + i];
                sm += __shfl_xor(sm, 1); sm += __shfl_xor(sm, 2);
                if (q == 0) { const size_t idx = (size_t)(b * SEQ + t0 + s) * S5_W + g * 16 + c;
                    if (dir == 0) ys5[idx] = dsk[g * 16 + c] * u_s[s][c] + sm;
                    else { const float y = ys5[idx] + sm; ys5[idx] = y; Z[idx] = (bf16)f2bf(gelu_tanh(y)); } }
                __syncthreads();
            }
        }
    }
}
__global__ void __launch_bounds__(256) naive_post(const bf16* proj, const float* oret, const float* ogla, bf16* Y, int do_ret, int do_gla) {
    const int m = blockIdx.x * 4 + (threadIdx.x >> 6), lane = threadIdx.x & 63;
    for (int h = 0; h < (do_ret ? 4 : 0); ++h) {
        float v[4]; float s = 0.f;
#pragma unroll
        for (int j = 0; j < 4; ++j) { v[j] = oret[(size_t)m * 1024 + h * 256 + j * 64 + lane]; s += v[j]; }
        const float mu = wave_sum(s) * (1.0f / 256.0f); float q = 0.f;
#pragma unroll
        for (int j = 0; j < 4; ++j) { v[j] -= mu; q += v[j] * v[j]; }
        const float rstd = 1.0f / sqrtf(wave_sum(q) * (1.0f / 256.0f) + EPS);
#pragma unroll
        for (int j = 0; j < 4; ++j) { const int c = h * 256 + j * 64 + lane; const float gt = bf2f(proj[(size_t)m * NINP + PC_RG + c]); Y[(size_t)m * D + c] = (bf16)f2bf(gt / (1.0f + expf(-gt)) * v[j] * rstd); }
    }
    for (int h = 0; h < (do_gla ? 4 : 0); ++h) {
        float v[2]; float q = 0.f;
#pragma unroll
        for (int j = 0; j < 2; ++j) { v[j] = ogla[(size_t)m * 512 + h * 128 + j * 64 + lane]; q += v[j] * v[j]; }
        const float rstd = 1.0f / sqrtf(wave_sum(q) * (1.0f / 128.0f) + EPS);
#pragma unroll
        for (int j = 0; j < 2; ++j) { const int c = h * 128 + j * 64 + lane; const float gt = bf2f(proj[(size_t)m * NINP + PC_GR + c]); Y[(size_t)m * D + 1536 + c] = (bf16)f2bf(gt / (1.0f + expf(-gt)) * v[j] * rstd); }
    }
}

static void launch_mega(const Args& base, int lo, int hi, int& li, int grid, hipStream_t stream) {
    Args a = base; a.ph_lo = lo; a.ph_hi = hi; a.li = li++;
    hipLaunchKernelGGL(mega, dim3(grid), dim3(NWAVES * 64), LDS_BYTES, stream, a);
}
extern "C" void kernel_launch(void* const* d_in, const int* in_sizes, int n_in, void* d_out, int out_size, void* d_ws, size_t ws_size, hipStream_t stream) {
    static int grid = 0;
    if (grid == 0) {
        if (n_in != 28 || in_sizes[0] != M * D || out_size != M * D || ws_size < WS_END) { fprintf(stderr, "kernel_launch: unexpected shapes: n_in %d in0 %d out %d ws %zu (need %zu)\n", n_in, n_in > 0 ? in_sizes[0] : -1, out_size, ws_size, (size_t)WS_END); grid = -1; return; }
        int dev = 0, cus = 0, per_cu = 0;
        if (hipGetDevice(&dev) != hipSuccess || hipDeviceGetAttribute(&cus, hipDeviceAttributeMultiprocessorCount, dev) != hipSuccess) { grid = -1; return; }
        if (hipFuncSetAttribute((const void*)mega, hipFuncAttributeMaxDynamicSharedMemorySize, LDS_BYTES) != hipSuccess) { fprintf(stderr, "kernel_launch: hipFuncSetAttribute failed\n"); grid = -1; return; }
        if (hipOccupancyMaxActiveBlocksPerMultiprocessor(&per_cu, (const void*)mega, NWAVES * 64, LDS_BYTES) != hipSuccess || per_cu < 1) fprintf(stderr, "kernel_launch: occupancy query reports %d\n", per_cu);
        (void)hipGetLastError();
        grid = cus;
    }
    if (grid < 0) return;
    hipMemsetAsync((char*)d_ws + WS_CTL, 0, CTL_ZERO_BYTES, stream);
    Args a{};
    for (int i = 0; i < 28; ++i) a.in[i] = (const float*)d_in[i];
    a.out = (float*)d_out; a.ws = (unsigned char*)d_ws;
    unsigned char* ws = (unsigned char*)d_ws;
    int li = 0;
#if MK_MODE == 0
    launch_mega(a, 0, 1, li, grid, stream);
    for (int l = 0; l < DEPTH; ++l) {
        const int pb = 1 + l * NP;
        for (int k = 0; k <= 4; ++k) launch_mega(a, pb + k, pb + k + 1, li, grid, stream);
        const bf16* proj = (const bf16*)(ws + WS_PROJ); float* la = (float*)(ws + WS_LA); float* oret = (float*)(ws + WS_ORET); float* ogla = (float*)(ws + WS_OGLA); float* ys5 = (float*)(ws + WS_YS5);
        if (!(FAST_MASK & 1)) hipLaunchKernelGGL(naive_la, dim3(M), dim3(512), 0, stream, proj, a.in[I_WGATE] + (size_t)l * 2 * 16 * 256, a.in[I_BGATE] + (size_t)l * 2 * 256, la);
        for (int dir = 0; dir < 2; ++dir) {
            if (!(FAST_MASK & 2)) hipLaunchKernelGGL((naive_linrec<128, 256, 0>), dim3(BATCH * 4 * 8), dim3(256), 0, stream, proj, (const float*)la, oret, dir);
            if (!(FAST_MASK & 1)) hipLaunchKernelGGL((naive_linrec<64, 128, 1>), dim3(BATCH * 4 * 4), dim3(256), 0, stream, proj, (const float*)la, ogla, dir);
        }
        for (int kk = 5; kk <= 7; ++kk) launch_mega(a, pb + kk, pb + kk + 1, li, grid, stream);
        if ((FAST_MASK & 3) != 3) hipLaunchKernelGGL(naive_post, dim3(M / 4), dim3(256), 0, stream, proj, (const float*)oret, (const float*)ogla, (bf16*)(ws + WS_Y), (FAST_MASK & 2) ? 0 : 1, (FAST_MASK & 1) ? 0 : 1);
        for (int k = 8; k <= 12; ++k) launch_mega(a, pb + k, pb + k + 1, li, grid, stream);
    }
    launch_mega(a, PH_FINAL, PH_END, li, grid, stream);
#else
    launch_mega(a, 0, PH_END, li, grid, stream);
#endif
}
```

```cpp
#ifndef MK_MODE
#define MK_MODE 1
#endif
#ifndef FAST_MASK
#define FAST_MASK 3
#endif
#ifndef PROBE_DUP
#define PROBE_DUP 0
#define STAGGER_TICKS 0
#define STAGGER_XCD 1
#define LOCAL_BARS 1
#define TEAM_SPLIT 0
#endif
#include <hip/hip_runtime.h>
#include <cstdio>
#include <cstdint>
__device__ __forceinline__ int lane_now() { int l; asm volatile("v_mbcnt_lo_u32_b32 %0, -1, 0\n\tv_mbcnt_hi_u32_b32 %0, -1, %0" : "=v"(l)); return l; }
typedef _Float16 h16; typedef _Float16 h16x4 __attribute__((ext_vector_type(4)));
namespace pg8 {
#define PG8_LAS __attribute__((address_space(3)))
typedef unsigned short bf16_t;
typedef short bf16x8 __attribute__((ext_vector_type(8)));
typedef float f32x4 __attribute__((ext_vector_type(4)));
typedef unsigned u32x4 __attribute__((ext_vector_type(4)));
constexpr int BM = 256, BK = 64, HALF = 128, HTB = HALF * BK * 2  , STAGE_BYTES = 8 * HTB, NXCD = 8, WGM = 8;

__host__ __device__ __forceinline__ int lds_byte(int r, int c) { const int st = (r >> 4) * 2 + (c >> 5), rr = r & 15, cc = c & 31, ob = rr * 64 + cc * 2; return st * 1024 + (ob ^ (((ob >> 9) & 1) << 5)); }
__host__ __device__ __forceinline__ void stage_rc(int b, int& R, int& C) { const int st = b / 1024, sb = b % 1024, swz = sb ^ (((sb >> 9) & 1) << 5); R = (st >> 1) * 16 + swz / 64; C = (st & 1) * 32 + (swz % 64) / 2; }
__host__ __device__ __forceinline__ int perm32(int rho) { const int n = rho >> 4, i = rho & 15; return 8 * (i >> 2) + 4 * n + (i & 3); }

struct Unit { int pm, pn, g; };
struct Gemm { const bf16_t* A; const bf16_t* Bt; int M, N, K; int lda, ldb; size_t sA, sB;
    __device__ __forceinline__ size_t a_off(const Unit& u) const { return ((size_t)u.g * sA + (size_t)u.pm * BM * lda) * 2; }
    __device__ __forceinline__ size_t b_off(const Unit& u) const { return ((size_t)u.g * sB + (size_t)u.pn * BM * ldb) * 2; } };
__device__ __forceinline__ Gemm mk_gemm(const bf16_t* A, const bf16_t* Bt, int M, int N, int K) { Gemm g; g.A = A; g.Bt = Bt; g.M = M; g.N = N; g.K = K; g.lda = K; g.ldb = K; g.sA = 0; g.sB = 0; return g; }

struct StaticOrder {
    int nM, nN, nwg, G, c, alt, pm0;
    __host__ __device__ void init(int M, int N, int G_, int c_) { nM = M / BM; nN = N / BM; nwg = nM * nN; G = G_; c = c_; alt = 0; pm0 = 0; }
    __host__ __device__ bool next(int i, Unit& u) const {
        const long L = (long)i * G + c; if (L >= nwg) return false;
        int wgid = (int)L; { const int q = nwg / NXCD, r = nwg % NXCD, xcd = wgid % NXCD, off = wgid / NXCD; wgid = (xcd < r ? xcd * (q + 1) : r * (q + 1) + (xcd - r) * q) + off; }
        const int nig = WGM * nN, gid = wgid / nig, fm = gid * WGM, gsz = (nM - fm) < WGM ? (nM - fm) : WGM;
        if (alt) { const int w = wgid % nig, idx = w & 31; u.pm = fm + 4 * (w >> 5) + (idx & 3); u.pn = idx >> 2; }
        else { u.pm = fm + ((wgid % nig) % gsz); u.pn = (wgid % nig) / gsz; }
        u.pm += pm0; u.g = 0; return true;
    }
    __device__ __forceinline__ void a_ready(const Unit&) const {}
    __device__ __forceinline__ void done(const Unit&) const {}
};
struct BatchOrder {
    int nM, nN, nb, G, c, pm0;
    __device__ __forceinline__ void init(int M, int N, int nb_, int G_, int c_) { nM = M / BM; nN = N / BM; nb = nb_; G = G_; c = c_; pm0 = 0; }
    __device__ __forceinline__ bool next(int i, Unit& u) const { const int L = i * G + c; if (L >= nb * nM * nN) return false; u.pn = L % nN; const int r = L / nN; u.pm = r % nM + pm0; u.g = r / nM; return true; }
    __device__ __forceinline__ void a_ready(const Unit&) const {}
    __device__ __forceinline__ void done(const Unit&) const {}
};

__device__ __forceinline__ unsigned cvt_pk_bf16(float lo, float hi) { unsigned r; asm volatile("v_cvt_pk_bf16_f32 %0, %1, %2" : "=v"(r) : "v"(lo), "v"(hi)); return r; }
typedef float f32x2 __attribute__((ext_vector_type(2)));
__device__ __forceinline__ float fast_sigmoid(float a) { return __builtin_amdgcn_rcpf(1.0f + __expf(-a)); }
struct EpiProj {
    static constexpr bool PERM = true, AFTER_DRAIN = false;
    bf16_t* O; int ldc; const float* rcos; const float* rsin; bf16_t* sua;
    __device__ __forceinline__ void operator()(const f32x4 (&acc)[2][2][4][2], const Unit& u, int wr, int wc, int fr, int fq) const {
        const int row0 = u.pm * BM + wr * 64 + fr;
        if (u.pn < 4) {
            const int c128 = wc * 32 + 8 * fq, hl = c128 >> 6, dl0 = c128 & 63; const float sc = (u.pn < 2) ? 0.08838834764831845f : 1.0f;
            const int colb = (u.pn < 2 ? 0 : 512) + ((u.pn & 1) * 2 + hl) * 128 + dl0;
#pragma unroll
            for (int ai = 0; ai < 2; ++ai) {
                f32x4 tc0[4], tc1[4], ts0[4], ts1[4];
#pragma unroll
                for (int m = 0; m < 4; ++m) { const int pos = (row0 + ai * HALF + m * 16) & 4095;
                    tc0[m] = *(const f32x4*)(rcos + pos * 64 + dl0); tc1[m] = *(const f32x4*)(rcos + pos * 64 + dl0 + 4); ts0[m] = *(const f32x4*)(rsin + pos * 64 + dl0); ts1[m] = *(const f32x4*)(rsin + pos * 64 + dl0 + 4); }
#pragma unroll
                for (int m = 0; m < 4; ++m) { const int row = row0 + ai * HALF + m * 16;
                    const f32x4 c0 = tc0[m], c1 = tc1[m], s0 = ts0[m], s1 = ts1[m];
                    const f32x4 a0 = acc[ai][0][m][0] * sc, a1 = acc[ai][0][m][1] * sc, b0 = acc[ai][1][m][0] * sc, b1 = acc[ai][1][m][1] * sc;
                    const f32x4 x0 = a0 * c0 - b0 * s0, x1 = a1 * c1 - b1 * s1, y0 = a0 * s0 + b0 * c0, y1 = a1 * s1 + b1 * c1;
                    u32x4 w; w.x = cvt_pk_bf16(x0[0], x0[1]); w.y = cvt_pk_bf16(x0[2], x0[3]); w.z = cvt_pk_bf16(x1[0], x1[1]); w.w = cvt_pk_bf16(x1[2], x1[3]);
                    u32x4 v; v.x = cvt_pk_bf16(y0[0], y0[1]); v.y = cvt_pk_bf16(y0[2], y0[3]); v.z = cvt_pk_bf16(y1[0], y1[1]); v.w = cvt_pk_bf16(y1[2], y1[3]);
                    bf16_t* rowp = O + (size_t)row * ldc + colb; *(u32x4*)rowp = w; *(u32x4*)(rowp + 64) = v; }
                asm volatile("" ::: "memory"); }
            return;
        }
        const int col0 = u.pn * BM + wc * 32 + 8 * fq; const float sc = (u.pn == 14) ? 0.125f : 1.0f; const bool is_su = (u.pn == 12 || u.pn == 13);
#pragma unroll
        for (int ai = 0; ai < 2; ++ai)
#pragma unroll
            for (int m = 0; m < 4; ++m) { const int row = row0 + ai * HALF + m * 16; bf16_t* rowp = O + (size_t)row * ldc + col0;
#pragma unroll
                for (int bj = 0; bj < 2; ++bj) { const f32x4 v0 = acc[ai][bj][m][0] * sc, v1 = acc[ai][bj][m][1] * sc;
                    u32x4 w; w.x = cvt_pk_bf16(v0[0], v0[1]); w.y = cvt_pk_bf16(v0[2], v0[3]); w.z = cvt_pk_bf16(v1[0], v1[1]); w.w = cvt_pk_bf16(v1[2], v1[3]);
                    *(u32x4*)(rowp + bj * HALF) = w;
                    if (is_su) { const int ch = col0 + bj * HALF - 3072; *(u32x4*)(sua + ((size_t)(ch >> 4) * 512 + (row >> 5)) * 768 + (row & 31) * 16 + (ch & 15)) = w; } } }
    }
};
struct EpiS5State {
    static constexpr bool PERM = false, AFTER_DRAIN = false;
    float* SC;
    __device__ __forceinline__ void operator()(const f32x4 (&acc)[2][2][4][2], const Unit& u, int wr, int wc, int fr, int fq) const {
        const int row0 = u.pm * BM + wr * 64 + fr, col0 = wc * 32 + 4 * fq;
#pragma unroll
        for (int ai = 0; ai < 2; ++ai)
#pragma unroll
            for (int m = 0; m < 4; ++m) { float* rowp = SC + ((size_t)u.g * 512 + row0 + ai * HALF + m * 16) * 256 + col0;
#pragma unroll
                for (int bj = 0; bj < 2; ++bj)
#pragma unroll
                    for (int n = 0; n < 2; ++n) *(f32x4*)(rowp + bj * HALF + n * 16) = acc[ai][bj][m][n]; }
    }
};
__device__ __forceinline__ float gelu_tanh_f(float x) { const float u = 0.7978845608028654f * (x + 0.044715f * x * x * x); const float e = __expf(2.0f * u); return x - x * __builtin_amdgcn_rcpf(e + 1.0f); }
struct EpiS5Out {
    static constexpr bool PERM = true, AFTER_DRAIN = false;
    bf16_t* Z;
    __device__ __forceinline__ void operator()(const f32x4 (&acc)[2][2][4][2], const Unit& u, int wr, int wc, int fr, int fq) const {
        const int row0 = u.pm * BM + wr * 64 + fr, col0 = u.pn * BM + wc * 32 + 8 * fq;
#pragma unroll
        for (int ai = 0; ai < 2; ++ai)
#pragma unroll
            for (int m = 0; m < 4; ++m) { const int chunk = row0 + ai * HALF + m * 16;
#pragma unroll
                for (int bj = 0; bj < 2; ++bj) { const int col = col0 + bj * HALF, t = col >> 4, cp = col & 15; const f32x4 v0 = acc[ai][bj][m][0], v1 = acc[ai][bj][m][1];
                    u32x4 w; w.x = cvt_pk_bf16(gelu_tanh_f(v0[0]), gelu_tanh_f(v0[1])); w.y = cvt_pk_bf16(gelu_tanh_f(v0[2]), gelu_tanh_f(v0[3])); w.z = cvt_pk_bf16(gelu_tanh_f(v1[0]), gelu_tanh_f(v1[1])); w.w = cvt_pk_bf16(gelu_tanh_f(v1[2]), gelu_tanh_f(v1[3]));
                    *(u32x4*)(Z + ((size_t)chunk * 32 + t) * 512 + u.g * 16 + cp) = w; } }
    }
};
struct EpiSwiGLU {
    static constexpr bool PERM = true, AFTER_DRAIN = false;
    bf16_t* O; int ldc;
    __device__ __forceinline__ void operator()(const f32x4 (&acc)[2][2][4][2], const Unit& u, int wr, int wc, int fr, int fq) const {
        const int row0 = u.pm * BM + wr * 64 + fr, col0 = u.pn * HALF + wc * 32 + 8 * fq;
#pragma unroll
        for (int ai = 0; ai < 2; ++ai)
#pragma unroll
            for (int m = 0; m < 4; ++m) { bf16_t* rowp = O + (size_t)(row0 + ai * HALF + m * 16) * ldc + col0;
                float r[8];
#pragma unroll
                for (int n = 0; n < 2; ++n)
#pragma unroll
                    for (int j = 0; j < 4; j += 2) {
                        const f32x2 a = (f32x2){acc[ai][0][m][n][j], acc[ai][0][m][n][j + 1]}, b = (f32x2){acc[ai][1][m][n][j], acc[ai][1][m][n][j + 1]};
                        const f32x2 t = a * -1.4426950408889634f; const f32x2 e = (f32x2){__builtin_amdgcn_exp2f(t.x), __builtin_amdgcn_exp2f(t.y)} + 1.0f;
                        const f32x2 o = (a * b) * (f32x2){__builtin_amdgcn_rcpf(e.x), __builtin_amdgcn_rcpf(e.y)}; r[n * 4 + j] = o.x; r[n * 4 + j + 1] = o.y; }
                u32x4 w; w.x = cvt_pk_bf16(r[0], r[1]); w.y = cvt_pk_bf16(r[2], r[3]); w.z = cvt_pk_bf16(r[4], r[5]); w.w = cvt_pk_bf16(r[6], r[7]);
                *(u32x4*)rowp = w; }
    }
};
struct EpiResid {
    static constexpr bool PERM = true, AFTER_DRAIN = false;
    const h16* base; h16* out; int ldc; const float* gate; int gstride; float coef;
    __device__ __forceinline__ void operator()(const f32x4 (&acc)[2][2][4][2], const Unit& u, int wr, int wc, int fr, int fq) const {
        typedef _Float16 h16x8 __attribute__((ext_vector_type(8)));
        const int row0 = u.pm * BM + wr * 64 + fr, col0 = u.pn * BM + wc * 32 + 8 * fq;
        const float* gp = gate + (size_t)(u.pm >> 4) * gstride + col0;
        f32x4 gv[2][2];
#pragma unroll
        for (int bj = 0; bj < 2; ++bj)
#pragma unroll
            for (int n = 0; n < 2; ++n) gv[bj][n] = *(const f32x4*)(gp + bj * HALF + n * 4) * coef;
#pragma unroll
        for (int ai = 0; ai < 2; ++ai) {
            h16x8 bs[4][2];
#pragma unroll
            for (int m = 0; m < 4; ++m) { const size_t off = (size_t)(row0 + ai * HALF + m * 16) * ldc + col0;
#pragma unroll
                for (int bj = 0; bj < 2; ++bj) bs[m][bj] = *(const h16x8*)(base + off + bj * HALF); }
#pragma unroll
            for (int m = 0; m < 4; ++m) { const size_t off = (size_t)(row0 + ai * HALF + m * 16) * ldc + col0;
#pragma unroll
                for (int bj = 0; bj < 2; ++bj) { const h16x8 b8 = bs[m][bj];
                    const f32x4 lo = __builtin_convertvector(__builtin_shufflevector(b8, b8, 0, 1, 2, 3), f32x4) + gv[bj][0] * acc[ai][bj][m][0];
                    const f32x4 hi = __builtin_convertvector(__builtin_shufflevector(b8, b8, 4, 5, 6, 7), f32x4) + gv[bj][1] * acc[ai][bj][m][1];
                    const h16x4 l4 = __builtin_convertvector(lo, h16x4), h4 = __builtin_convertvector(hi, h16x4);
                    *(h16x8*)(out + off + bj * HALF) = __builtin_shufflevector(l4, h4, 0, 1, 2, 3, 4, 5, 6, 7); } }
            asm volatile("" ::: "memory"); }
    }
};
struct EpiGlu {
    static constexpr bool PERM = true, AFTER_DRAIN = false;
    const bf16_t* Z; int ldz; bf16_t* Y; int ldy; int ycol0; const float* bias;
    __device__ __forceinline__ void operator()(const f32x4 (&acc)[2][2][4][2], const Unit& u, int wr, int wc, int fr, int fq) const {
        const int row0 = u.pm * BM + wr * 64 + fr, col0 = u.pn * BM + wc * 32 + 8 * fq;
        f32x4 bv[2][2];
#pragma unroll
        for (int bj = 0; bj < 2; ++bj)
#pragma unroll
            for (int n = 0; n < 2; ++n) bv[bj][n] = *(const f32x4*)(bias + col0 + bj * HALF + 4 * n);
#pragma unroll
        for (int ai = 0; ai < 2; ++ai)
#pragma unroll
            for (int m = 0; m < 4; ++m) { const size_t r = (size_t)(row0 + ai * HALF + m * 16);
#pragma unroll
                for (int bj = 0; bj < 2; ++bj) { const u32x4 zz = *(const u32x4*)(Z + r * ldz + col0 + bj * HALF);
                    const f32x4 v0 = acc[ai][bj][m][0] + bv[bj][0], v1 = acc[ai][bj][m][1] + bv[bj][1];
                    float o[8];
#pragma unroll
                    for (int j = 0; j < 4; ++j) { const unsigned zw = zz[j]; const float zl = __uint_as_float(zw << 16), zh = __uint_as_float(zw & 0xffff0000u);
                        const float g0 = (j < 2) ? v0[2 * j] : v1[2 * j - 4], g1 = (j < 2) ? v0[2 * j + 1] : v1[2 * j - 3];
                        o[2 * j] = zl * fast_sigmoid(g0); o[2 * j + 1] = zh * fast_sigmoid(g1); }
                    u32x4 w; w.x = cvt_pk_bf16(o[0], o[1]); w.y = cvt_pk_bf16(o[2], o[3]); w.z = cvt_pk_bf16(o[4], o[5]); w.w = cvt_pk_bf16(o[6], o[7]);
                    *(u32x4*)(Y + r * ldy + ycol0 + col0 + bj * HALF) = w; }
                asm volatile("" ::: "memory"); }
    }
};
template <class Epi, class Sched, bool ALIGN_EPI = false, bool SP2 = false>
__device__ __forceinline__ void gemm_phase(PG8_LAS unsigned char* lds, const Gemm g, const Sched& S, const Epi& E, const int wave_id) {
    const int lane = lane_now(), wid = wave_id, tid = wid * 64 + lane, wr = wid >> 2, wc = wid & 3, fr = lane & 15, fq = lane >> 4;
    const int K = g.K, nt = K / BK;
    unsigned voffA[2], voffB[2];
#pragma unroll
    for (int i = 0; i < 2; ++i) { int R, C; stage_rc(tid * 16 + i * 8192, R, C); const int Rb = Epi::PERM ? ((R & ~31) + perm32(R & 31)) : R;
        voffA[i] = (unsigned)(R * g.lda + C) * 2u; voffB[i] = (unsigned)(Rb * g.ldb + C) * 2u; }
    const size_t kstep = (size_t)(BK * 2);
    const size_t hstepA = (size_t)HALF * g.lda * 2, hstepB = (size_t)HALF * g.ldb * 2;
    const unsigned ldsw = (unsigned)wid * 1024u;
    const int aoff = lds_byte(wr * 64 + fr, fq * 8), boff = lds_byte(wc * 32 + fr, fq * 8);
#define PG8_SA(b, h) (((b) * 2 + (h)) * HTB)
#define PG8_SB(b, h) ((4 + (b) * 2 + (h)) * HTB)
#define PG8_STAGE(bufoff, gbase, voff) do { _Pragma("unroll") for (int _i = 0; _i < 2; ++_i) \
        __builtin_amdgcn_global_load_lds((const unsigned*)((const char*)(gbase) + (voff)[_i]), (PG8_LAS unsigned*)(lds + (bufoff) + ldsw + _i * 8192), 16, 0, 0); } while (0)
#define PG8_LDA(dst, b, h) do { _Pragma("unroll") for (int m = 0; m < 4; ++m) _Pragma("unroll") for (int k = 0; k < 2; ++k) dst[m][k] = *(const PG8_LAS bf16x8*)(lds + PG8_SA(b, h) + aoff + m * 2048 + k * 1024); } while (0)
#define PG8_LDB(dst, b, h) do { _Pragma("unroll") for (int n = 0; n < 2; ++n) _Pragma("unroll") for (int k = 0; k < 2; ++k) dst[n][k] = *(const PG8_LAS bf16x8*)(lds + PG8_SB(b, h) + boff + n * 2048 + k * 1024); } while (0)
#define PG8_MMA(ai, bj, At, Bt) do { __builtin_amdgcn_s_setprio(1); _Pragma("unroll") for (int m = 0; m < 4; ++m) _Pragma("unroll") for (int n = 0; n < 2; ++n) _Pragma("unroll") for (int k = 0; k < 2; ++k) \
        acc[ai][bj][m][n] = __builtin_amdgcn_mfma_f32_16x16x32_bf16(Bt[n][k], At[m][k], acc[ai][bj][m][n], 0, 0, 0); __builtin_amdgcn_s_setprio(0); } while (0)
#define PG8_WAIT_V(n) asm volatile("s_waitcnt vmcnt(" #n ")" ::: "memory")
#define PG8_WAIT_L(n) asm volatile("s_waitcnt lgkmcnt(" #n ")" ::: "memory")
#define PG8_BAR __builtin_amdgcn_s_barrier()
#define PG8_SCHED __builtin_amdgcn_sched_barrier(0)
    Unit cur, nxt; int ui = 0;
    if (!S.next(0, cur)) return;
    f32x4 acc[2][2][4][2];
#pragma unroll
    for (int a = 0; a < 2; ++a)
#pragma unroll
        for (int b = 0; b < 2; ++b)
#pragma unroll
            for (int m = 0; m < 4; ++m)
#pragma unroll
                for (int n = 0; n < 2; ++n) acc[a][b][m][n] = (f32x4){0.f, 0.f, 0.f, 0.f};
    bf16x8 At[4][2], B0[2][2], B1[2][2];
    const char* cA = (const char*)g.A + g.a_off(cur); const char* cB = (const char*)g.Bt + g.b_off(cur);
    S.a_ready(cur);
    if constexpr (SP2) {
        PG8_STAGE(PG8_SB(0, 0), cB, voffB); PG8_STAGE(PG8_SB(0, 1), cB + hstepB, voffB); PG8_STAGE(PG8_SA(0, 0), cA, voffA); PG8_STAGE(PG8_SA(0, 1), cA + hstepA, voffA);
        if (wr == 1) PG8_BAR;
        PG8_WAIT_V(2); PG8_BAR;
        PG8_STAGE(PG8_SB(1, 0), cB + kstep, voffB); PG8_STAGE(PG8_SA(1, 0), cA + kstep, voffA); PG8_STAGE(PG8_SB(1, 1), cB + hstepB + kstep, voffB);
        PG8_WAIT_V(6); PG8_BAR;
    } else {
        PG8_STAGE(PG8_SB(0, 0), cB, voffB); PG8_STAGE(PG8_SA(0, 0), cA, voffA); PG8_STAGE(PG8_SB(0, 1), cB + hstepB, voffB); PG8_STAGE(PG8_SA(0, 1), cA + hstepA, voffA);
        if (wr == 1) PG8_BAR;
        PG8_WAIT_V(4); PG8_BAR;
        PG8_STAGE(PG8_SB(1, 0), cB + kstep, voffB); PG8_STAGE(PG8_SA(1, 0), cA + kstep, voffA); PG8_STAGE(PG8_SB(1, 1), cB + hstepB + kstep, voffB);
        PG8_WAIT_V(6); PG8_BAR;
    }
    for (;;) {
        const bool has_next = S.next(ui + 1, nxt);
        const char* nA = has_next ? (const char*)g.A + g.a_off(nxt) : cA; const char* nB = has_next ? (const char*)g.Bt + g.b_off(nxt) : cB;
        for (int t = 0; t < nt; t += 2) {
            const bool last = (t == nt - 2);
            const char* a1 = cA + (size_t)(t + 1) * kstep;
            const char* a2 = last ? nA : cA + (size_t)(t + 2) * kstep; const char* b2 = last ? nB : cB + (size_t)(t + 2) * kstep;
            const char* a3 = a2 + kstep; const char* b3 = b2 + kstep;
            if (last && has_next) S.a_ready(nxt);
            if constexpr (SP2) {
            PG8_LDB(B0, 0, 0); PG8_LDB(B1, 0, 1); PG8_SCHED; PG8_LDA(At, 0, 0); PG8_STAGE(PG8_SA(1, 1), a1 + hstepA, voffA);
            PG8_WAIT_V(8); PG8_WAIT_L(0); PG8_BAR; PG8_MMA(0, 0, At, B0); PG8_MMA(0, 1, At, B1); PG8_BAR; PG8_SCHED;
            PG8_LDA(At, 0, 1); PG8_STAGE(PG8_SB(0, 0), b2, voffB); PG8_STAGE(PG8_SB(0, 1), b2 + hstepB, voffB); PG8_STAGE(PG8_SA(0, 0), a2, voffA);
            PG8_WAIT_V(8); PG8_WAIT_L(0); PG8_BAR; PG8_MMA(1, 0, At, B0); PG8_MMA(1, 1, At, B1); PG8_BAR; PG8_SCHED;
            PG8_LDB(B0, 1, 0); PG8_LDB(B1, 1, 1); PG8_SCHED; PG8_LDA(At, 1, 0); PG8_STAGE(PG8_SA(0, 1), a2 + hstepA, voffA);
            PG8_WAIT_V(8); PG8_WAIT_L(0); PG8_BAR; PG8_MMA(0, 0, At, B0); PG8_MMA(0, 1, At, B1); PG8_BAR; PG8_SCHED;
            PG8_LDA(At, 1, 1); PG8_STAGE(PG8_SB(1, 0), b3, voffB); PG8_STAGE(PG8_SB(1, 1), b3 + hstepB, voffB); PG8_STAGE(PG8_SA(1, 0), a3, voffA);
            PG8_WAIT_V(8); PG8_WAIT_L(0); PG8_BAR; PG8_MMA(1, 0, At, B0); PG8_MMA(1, 1, At, B1); PG8_BAR; PG8_SCHED;
            } else {
            PG8_LDB(B0, 0, 0); PG8_SCHED; PG8_LDA(At, 0, 0); PG8_STAGE(PG8_SA(1, 1), a1 + hstepA, voffA);
            PG8_WAIT_L(8); PG8_BAR; PG8_WAIT_L(0); PG8_MMA(0, 0, At, B0); PG8_BAR; PG8_SCHED;
            PG8_LDB(B1, 0, 1); PG8_STAGE(PG8_SB(0, 0), b2, voffB);
            PG8_BAR; PG8_WAIT_L(0); PG8_MMA(0, 1, At, B1); PG8_BAR;
            PG8_LDA(At, 0, 1); PG8_STAGE(PG8_SA(0, 0), a2, voffA);
            PG8_BAR; PG8_WAIT_L(0); PG8_MMA(1, 0, At, B0); PG8_BAR; PG8_SCHED;
            PG8_STAGE(PG8_SB(0, 1), b2 + hstepB, voffB);
            PG8_WAIT_V(6); PG8_BAR; PG8_MMA(1, 1, At, B1); PG8_BAR;
            PG8_LDB(B0, 1, 0); PG8_SCHED; PG8_LDA(At, 1, 0); PG8_STAGE(PG8_SA(0, 1), a2 + hstepA, voffA);
            PG8_WAIT_L(8); PG8_BAR; PG8_WAIT_L(0); PG8_MMA(0, 0, At, B0); PG8_BAR; PG8_SCHED;
            PG8_LDB(B1, 1, 1); PG8_STAGE(PG8_SB(1, 0), b3, voffB);
            PG8_BAR; PG8_WAIT_L(0); PG8_MMA(0, 1, At, B1); PG8_BAR;
            PG8_LDA(At, 1, 1); PG8_STAGE(PG8_SA(1, 0), a3, voffA);
            PG8_BAR; PG8_WAIT_L(0); PG8_MMA(1, 0, At, B0); PG8_BAR; PG8_SCHED;
            PG8_STAGE(PG8_SB(1, 1), b3 + hstepB, voffB);
            PG8_WAIT_V(6); PG8_BAR; PG8_MMA(1, 1, At, B1); PG8_BAR;
            }
        }
        if constexpr (ALIGN_EPI) { if (wr == 0) PG8_BAR; }
        if constexpr (!Epi::AFTER_DRAIN) { E(acc, cur, wr, wc, fr, fq); S.done(cur); }
        if (!has_next) break;
#pragma unroll
        for (int a = 0; a < 2; ++a)
#pragma unroll
            for (int b = 0; b < 2; ++b)
#pragma unroll
                for (int m = 0; m < 4; ++m)
#pragma unroll
                    for (int n = 0; n < 2; ++n) acc[a][b][m][n] = (f32x4){0.f, 0.f, 0.f, 0.f};
        cur = nxt; cA = nA; cB = nB; ++ui;
        if constexpr (ALIGN_EPI) { if (wr == 1) PG8_BAR; }
    }
    PG8_WAIT_V(0);
    if constexpr (!ALIGN_EPI) { if (wr == 0) PG8_BAR; }
    PG8_BAR;
    if constexpr (Epi::AFTER_DRAIN) { E.fused(acc, cur, wr, wc, fr, fq, lds, wid, lane); S.done(cur); }
#undef PG8_SA
#undef PG8_SB
#undef PG8_STAGE
#undef PG8_LDA
#undef PG8_LDB
#undef PG8_MMA
#undef PG8_WAIT_V
#undef PG8_WAIT_L
#undef PG8_BAR
#undef PG8_SCHED
}
}
#define GAS __attribute__((address_space(1)))
#define LAS __attribute__((address_space(3)))
typedef unsigned short bf16;
typedef unsigned v4u __attribute__((ext_vector_type(4)));
typedef float f32x4 __attribute__((ext_vector_type(4)));
typedef short bf16x8 __attribute__((ext_vector_type(8)));
typedef GAS unsigned gu32;
typedef GAS unsigned long long gu64;
#define RLX_AGENT __ATOMIC_RELAXED, __HIP_MEMORY_SCOPE_AGENT
#define LDS_WAIT() asm volatile("s_waitcnt lgkmcnt(0)" ::: "memory")
#define VM_WAIT() asm volatile("s_waitcnt vmcnt(0)" ::: "memory")
__device__ __forceinline__ unsigned long long rt() { return __builtin_amdgcn_s_memrealtime(); }
__device__ __forceinline__ unsigned f2bf(float f) { unsigned u = __builtin_bit_cast(unsigned, f); return (u + 0x7fffu + ((u >> 16) & 1u)) >> 16; }
__device__ __forceinline__ unsigned pk2(float lo, float hi) { return f2bf(lo) | (f2bf(hi) << 16); }

#define XB_TMO      128
#define XB_XCNT(j)  (256  + 64 * (j))
#define XB_XSUB(j)  (1280 + 64 * (j))
#define XB_XGEN(j)  (2304 + 64 * (j))
#define XB_TOP      3328
#define XB_TOPGEN   3392
#define XCD_BAR_WORDS 3456
#define XB_SPIN_CAP (1u << 18)

__device__ __forceinline__ unsigned xb_ld(unsigned* p)              { return __hip_atomic_load(p, __ATOMIC_RELAXED, __HIP_MEMORY_SCOPE_AGENT); }
__device__ __forceinline__ unsigned xb_add(unsigned* p, unsigned v) { return __hip_atomic_fetch_add(p, v, __ATOMIC_RELAXED, __HIP_MEMORY_SCOPE_AGENT); }
__device__ __forceinline__ unsigned xb_xcc_id() { return (unsigned)__builtin_amdgcn_s_getreg((3 << 11) | 20) & 0xFu; }
#define XB_SPIN(cond, bar) do { unsigned _sp = 0; while (cond) { __builtin_amdgcn_s_sleep(1); \
    if ((++_sp & 255u) == 0u) { if (xb_ld(&(bar)[XB_TMO])) break; if (_sp > XB_SPIN_CAP) { atomicAdd(&(bar)[XB_TMO], 1u); break; } } } } while (0)

struct XcdBarrier {
    unsigned* bar; unsigned x; bool w0; unsigned expect;
    volatile LAS unsigned* st;
};

__device__ __forceinline__ XcdBarrier xcd_barrier_post(unsigned* bar, volatile LAS unsigned* st) {
    XcdBarrier b; b.bar = bar; b.x = xb_xcc_id(); b.st = st; b.w0 = false; b.expect = 0u;
    if (threadIdx.x == 0) (void)xb_add(&bar[XB_XCNT(b.x)], 1u);
    return b;
}
__device__ __forceinline__ void xcd_barrier_complete(unsigned* bar, unsigned x, unsigned& nloc, unsigned& nx, const unsigned G) {
    unsigned sum, cnt, mine, sp = 0u;
    for (;;) {
        sum = 0u; cnt = 0u; mine = 0u;
#pragma unroll
        for (unsigned j = 0; j < 16; ++j) { const unsigned c = xb_ld(&bar[XB_XCNT(j)]); sum += c; cnt += (c > 0u) ? 1u : 0u; mine = (j == x) ? c : mine; }
        if (sum == G) break;
        __builtin_amdgcn_s_sleep(1);
        if ((++sp & 255u) == 0u) { if (xb_ld(&bar[XB_TMO])) break; if (sp > XB_SPIN_CAP) { atomicAdd(&bar[XB_TMO], 1u); break; } }
    }
    nloc = mine > 0u ? mine : 1u; nx = cnt > 0u ? cnt : 1u;
}

__device__ __forceinline__ void xcd_barrier(const XcdBarrier& b) {
    asm volatile("s_waitcnt vmcnt(0)" ::: "memory");
    __syncthreads();
    if (b.w0 && lane_now() == 0) {
        unsigned* bar = b.bar;
        __builtin_amdgcn_s_waitcnt(0);
        unsigned nloc = b.st[0], nx = b.st[1];
        if (nloc == 0u) { xcd_barrier_complete(bar, b.x, nloc, nx, b.expect); b.st[0] = nloc; b.st[1] = nx; }
        const unsigned old = xb_add(&bar[XB_XSUB(b.x)], 1u);
        const unsigned gen = old / nloc;
        if (old + 1u == (gen + 1u) * nloc) {
            __builtin_amdgcn_fence(__ATOMIC_RELEASE, "agent");
            asm volatile("s_waitcnt vmcnt(0)" ::: "memory");
            if (nx > 1u) {
            const unsigned og = xb_add(&bar[XB_TOP], 1u);
            const unsigned tg = og / nx;
            if (og + 1u == (tg + 1u) * nx) xb_add(&bar[XB_TOPGEN], 1u);
            else XB_SPIN(xb_ld(&bar[XB_TOPGEN]) == tg, bar);
            }
            __builtin_amdgcn_fence(__ATOMIC_ACQUIRE, "agent");
            xb_add(&bar[XB_XGEN(b.x)], 1u);
            asm volatile("s_waitcnt vmcnt(0)" ::: "memory");
        } else {
            XB_SPIN(xb_ld(&bar[XB_XGEN(b.x)]) == gen, bar);
            __builtin_amdgcn_fence(__ATOMIC_ACQUIRE, "agent");
            asm volatile("s_waitcnt vmcnt(0)" ::: "memory");
        }
    }
    __syncthreads();
}
constexpr int NWAVES = 8;
constexpr int BATCH = 4, SEQ = 4096, D = 2048, DEPTH = 4, M = BATCH * SEQ, FF = 5632, NIN = 5152, NINP = 5376, NMOD = 9, MODW = NMOD * D;
constexpr int RET_H = 4, RET_DK = 128, RET_DV = 256, S5_W = 512, S5_G = 32, S5_P = 64, S5_C = 16, GLA_H = 4, GLA_DK = 64, GLA_DV = 128, GLA_R = 16;
constexpr int PC_RQ = 0, PC_RK = 512, PC_RV = 1024, PC_RG = 2048, PC_SU = 3072, PC_GQ = 3584, PC_GK = 3840, PC_GV = 4096, PC_GR = 4608, PC_LR = 5120;
constexpr float EPS = 1e-6f;
constexpr size_t MiB = 1u << 20;
constexpr size_t WS_CTL = 0, CTL_ZERO_BYTES = 2 * MiB;
constexpr size_t WS_MOD = 2 * MiB;
constexpr size_t WS_ROT = 4 * MiB;
constexpr size_t WS_S5L = 6 * MiB;
constexpr size_t WS_S5B = 7 * MiB;
constexpr size_t WS_LA = 16 * MiB;
constexpr size_t WS_H = 48 * MiB;
constexpr size_t WS_U = 176 * MiB;
constexpr size_t WS_Y = 240 * MiB;
constexpr size_t WS_Z = 304 * MiB;
constexpr size_t WS_G = 320 * MiB;
constexpr size_t WS_PROJ = 496 * MiB;
constexpr size_t WS_ORET = 664 * MiB;
constexpr size_t WS_OGLA = 728 * MiB;
constexpr size_t WS_YS5 = 760 * MiB;
constexpr size_t WS_W = 800 * MiB;
constexpr size_t LW_13A = 0, LW_2A = 44 * MiB, LW_IN = 66 * MiB, LW_OUT = 87 * MiB, LW_GLU = 95 * MiB, LW_13B = 96 * MiB, LW_2B = 140 * MiB, LW_STRIDE = 162 * MiB;
constexpr size_t WS_S5LT = 10 * MiB;
constexpr size_t WS_SC = 1448 * MiB;
constexpr size_t WS_SUA = 1464 * MiB;
constexpr size_t WS_W1 = 1488 * MiB;
constexpr size_t WS_MF = 1520 * MiB;
constexpr size_t WS_KV_R = 1616 * MiB;
constexpr size_t WS_KV_G = 1744 * MiB;
constexpr size_t WS_DEC_R = 1776 * MiB;
constexpr size_t WS_DEC_G = 1777 * MiB;
constexpr int LDG = 5696;
constexpr size_t WS_G2 = 1792 * MiB;
constexpr size_t WS_W2P = 1984 * MiB;
constexpr size_t WS_END = 2176 * MiB;
static_assert(WS_W + DEPTH * LW_STRIDE <= WS_SC, "ws map");
constexpr int CW_BAR = 4096;
constexpr int MAX_BAR_REGIONS = 128;
constexpr int RING_OFF = 0, RING_BYTES = 131072;
constexpr int LDS_BYTES = 163840;
constexpr int LDSCTL_OFF = LDS_BYTES - 1024, MISC_OFF = LDSCTL_OFF + 320;
constexpr int CHUNK_LDS_MAX = LDSCTL_OFF;

struct Frame {
    LAS unsigned char* lds;
    volatile LAS unsigned* MISC;
    gu32* ctl;
    int tid, lane, wave;
    int vcu, G;
    int nt, hf, T, tr, tv;
};

__device__ __forceinline__ float wave_sum(float v) {
#pragma unroll
    for (int o = 1; o < 64; o <<= 1) v += __shfl_xor(v, o);
    return v;
}
__device__ __forceinline__ float wave_sum_l(float v, int lane) {
#pragma unroll
    for (int o = 1; o < 64; o <<= 1) v += __int_as_float(__builtin_amdgcn_ds_bpermute((lane ^ o) << 2, __float_as_int(v)));
    return v;
}
typedef __bf16 hbf2 __attribute__((ext_vector_type(2))); typedef float f32x2h __attribute__((ext_vector_type(2)));
__device__ __forceinline__ unsigned pkh(float lo, float hi) { const f32x2h v = {lo, hi}; return __builtin_bit_cast(unsigned, __builtin_convertvector(v, hbf2)); }
__device__ __forceinline__ float bf2f(bf16 b) { return __uint_as_float(((unsigned)b) << 16); }

struct TrItem { const float* W; bf16* WT; int N, ldw, rowbase, k0, n0; };
__device__ __forceinline__ void p0_tr_load(const TrItem& t, float (&wv)[32], int lane) {
#pragma unroll
    for (int i = 0; i < 32; ++i) wv[i] = t.W[(size_t)(t.k0 + 2 * i + (lane >> 5)) * t.N + t.n0 + (lane & 31)];
}
__device__ __forceinline__ void p0_tr_store(const TrItem& t, const float (&wv)[32], LAS float* scr, int lane) {
#pragma unroll
    for (int i = 0; i < 32; ++i) scr[(2 * i + (lane >> 5)) * 33 + (lane & 31)] = wv[i];
    LDS_WAIT(); asm volatile("" ::: "memory");
    const int c = lane & 7;
#pragma unroll
    for (int j = 0; j < 4; ++j) { const int n = (lane >> 3) + 8 * j; const LAS float* s = scr + (8 * c) * 33 + n;
        v4u o; o.x = pkh(s[0 * 33], s[1 * 33]); o.y = pkh(s[2 * 33], s[3 * 33]); o.z = pkh(s[4 * 33], s[5 * 33]); o.w = pkh(s[6 * 33], s[7 * 33]);
        *(GAS v4u*)(t.WT + (size_t)(t.rowbase + n) * t.ldw + t.k0 + 8 * c) = o; }
    LDS_WAIT(); asm volatile("" ::: "memory");
}

struct Args {
    const float* in[28]; float* out; unsigned char* ws;
    int ph_lo, ph_hi, li, pad;
};
typedef const __attribute__((address_space(4))) Args* KArgsP;
__device__ __forceinline__ KArgsP kargs() { KArgsP p = (KArgsP)__builtin_amdgcn_kernarg_segment_ptr(); asm volatile("" : "+s"(p)); return p; }
#define WSP(off) ((unsigned char*)kargs()->ws + (off))
#define INP(i) ((const float*)kargs()->in[i])
enum { I_X = 0, I_C, I_WADA, I_BADA, I_GFFN1, I_F1W1, I_F1W3, I_F1W2, I_GMIX, I_WIN, I_LRE, I_LIM, I_LDT, I_BRE, I_BIM, I_CRE, I_CIM, I_S5D, I_WGLU, I_BGLU, I_WGATE, I_BGATE, I_WOUT, I_GFFN2, I_F2W1, I_F2W3, I_F2W2, I_GFINAL };

__device__ __forceinline__ void p0_prologue(Frame& F) {
    unsigned char* ws = (unsigned char*)kargs()->ws;
    {
        LAS float* cond = (LAS float*)(F.lds + RING_OFF);
        LAS float* red = (LAS float*)(F.lds + RING_OFF + 32768);
        const float* c = kargs()->in[I_C];
        for (int i = F.tid; i < BATCH * D; i += NWAVES * 64) { const int b = i / D, k = i % D; const float v = c[i]; cond[k * 4 + b] = v / (1.0f + __expf(-v)); }
        __syncthreads();
        float* mod = (float*)(ws + WS_MOD);
        constexpr int NCB = MODW / 32;
        const int lane = lane_now(), col = lane & 31, kh = lane >> 5;
        for (int it = F.vcu; it < DEPTH * NCB; it += F.G) {
            const int l = it / NCB, j0 = (it % NCB) * 32;
            const int kb = F.wave * 256;
            const float* W = kargs()->in[I_WADA] + (size_t)l * D * MODW + (size_t)(kb + kh) * MODW + j0 + col;
            float acc0 = 0.f, acc1 = 0.f, acc2 = 0.f, acc3 = 0.f;
            float wv[2][32];
#pragma unroll
            for (int k = 0; k < 32; ++k) wv[0][k] = W[(size_t)(2 * k) * MODW];
#pragma unroll
            for (int ch = 0; ch < 4; ++ch) {
                if (ch < 3) {
#pragma unroll
                    for (int k = 0; k < 32; ++k) wv[(ch + 1) & 1][k] = W[(size_t)(64 * (ch + 1) + 2 * k) * MODW]; }
#pragma unroll
                for (int k = 0; k < 32; ++k) { const f32x4 cv = *(const LAS f32x4*)(cond + (kb + 64 * ch + 2 * k + kh) * 4); const float w = wv[ch & 1][k]; acc0 += cv[0] * w; acc1 += cv[1] * w; acc2 += cv[2] * w; acc3 += cv[3] * w; } }
            red[(F.wave * 4 + 0) * 64 + lane] = acc0; red[(F.wave * 4 + 1) * 64 + lane] = acc1; red[(F.wave * 4 + 2) * 64 + lane] = acc2; red[(F.wave * 4 + 3) * 64 + lane] = acc3;
            __syncthreads();
            if (F.tid < 128) { const int b = F.tid >> 5, cc = F.tid & 31; float s = 0.f;
#pragma unroll
                for (int w = 0; w < 8; ++w) s += red[(w * 4 + b) * 64 + cc] + red[(w * 4 + b) * 64 + 32 + cc];
                mod[((size_t)l * BATCH + b) * MODW + j0 + cc] = s + kargs()->in[I_BADA][(size_t)l * MODW + j0 + cc]; }
            __syncthreads();
        }
    }
    __syncthreads();
    const int gw = F.vcu * NWAVES + F.wave, NGW = F.G * NWAVES;
    const int gt = gw * 64 + F.lane, NGT = NGW * 64;
    {
        float* rc = (float*)(ws + WS_ROT); float* rs = rc + SEQ * 64;
        for (int i = gt; i < SEQ * 64; i += NGT) { const int pos = i >> 6, j = i & 63; const float invf = powf(10000.0f, -(float)(2 * j) / 128.0f); const float ang = (float)pos * invf; rc[i] = cosf(ang); rs[i] = sinf(ang); }
    }
    {
        typedef float f32x2 __attribute__((ext_vector_type(2)));
        LAS f32x2* POW = (LAS f32x2*)(F.lds + RING_OFF);
        LAS f32x2* BBl = (LAS f32x2*)(F.lds + RING_OFF + 33792);
        LAS f32x2* CCl = (LAS f32x2*)(F.lds + RING_OFF + 33792 + 16384);
        LAS float* KT = (LAS float*)(F.lds + RING_OFF + 33792 + 32768);
        for (int it = F.vcu; it < DEPTH * S5_G * 2; it += F.G) {
            const int l = it / (2 * S5_G), g = (it >> 1) % S5_G, hd = it & 1;
            __syncthreads();
            for (int i = F.tid; i < 33 * 64; i += NWAVES * 64) { const int p = i & 63, k = i >> 6; const int gi = ((l * 2 + hd) * S5_G + g) * S5_P + p;
                const float dt = expf(kargs()->in[I_LDT][(l * 2 + hd) * S5_G + g]); const float zr = kargs()->in[I_LRE][gi] * dt * (float)k, zi = kargs()->in[I_LIM][gi] * dt * (float)k; const float e = expf(zr);
                const f32x2 v = (f32x2){e * cosf(zi), e * sinf(zi)}; POW[hd * 33 * 64 + i] = v;
                if (k == 32) { float* lt = (float*)(ws + WS_S5LT); lt[2 * gi] = v.x; lt[2 * gi + 1] = v.y; } }
            for (int i = F.tid + hd * 1024; i < 2 * 64 * 16; i += NWAVES * 64) { const int c = i & 15, p = (i >> 4) & 63, dir = i >> 10; const int gi = ((l * 2 + dir) * S5_G + g) * S5_P + p;
                const float lre = kargs()->in[I_LRE][gi], lim = kargs()->in[I_LIM][gi], dt = expf(kargs()->in[I_LDT][(l * 2 + dir) * S5_G + g]); const float e = expf(lre * dt); const float br = e * cosf(lim * dt), bi = e * sinf(lim * dt);
                const float nr = br - 1.0f, ni = bi, den = lre * lre + lim * lim; const float cr = (nr * lre + ni * lim) / den, ci = (ni * lre - nr * lim) / den;
                const float xr = kargs()->in[I_BRE][(size_t)gi * 16 + c], xi = kargs()->in[I_BIM][(size_t)gi * 16 + c]; BBl[i] = (f32x2){cr * xr - ci * xi, cr * xi + ci * xr}; }
            for (int i = F.tid + hd * 1024; i < 2 * 16 * 64; i += NWAVES * 64) { const int p = i & 63, c = (i >> 6) & 15, dir = i >> 10; const size_t gi = ((size_t)((l * 2 + dir) * S5_G + g) * 16 + c) * S5_P + p;
                CCl[i] = (f32x2){kargs()->in[I_CRE][gi], kargs()->in[I_CIM][gi]}; }
            __syncthreads();
            { const int c = F.tid & 15, cp = (F.tid >> 4) & 15, k0 = (F.tid >> 8) ? 0 : 1; float cbx[64], cby[64];
#pragma unroll
              for (int p = 0; p < 64; ++p) { const f32x2 cc = CCl[(hd * 16 + cp) * 64 + p], bb = BBl[(hd * 64 + p) * 16 + c]; cbx[p] = cc.x * bb.x - cc.y * bb.y; cby[p] = cc.x * bb.y + cc.y * bb.x; }
              for (int k = k0 + 2 * (hd & (k0 == 0)); k < 32; k += 2) { const LAS f32x4* pw = (const LAS f32x4*)(POW + (hd * 33 + k) * 64); float a0 = 0.f, a1 = 0.f;
#pragma unroll
                  for (int p2 = 0; p2 < 32; ++p2) { const f32x4 w = pw[p2]; a0 += cbx[2 * p2] * w.x - cby[2 * p2] * w.y; a1 += cbx[2 * p2 + 1] * w.z - cby[2 * p2 + 1] * w.w; }
                  float acc = a0 + a1;
                  if (k == 0) { if (c == cp) acc += kargs()->in[I_S5D][l * S5_W + g * 16 + c];
                      for (int p = 0; p < 64; ++p) { const f32x2 cc = CCl[(16 + cp) * 64 + p], bb = BBl[(64 + p) * 16 + c]; acc += cc.x * bb.x - cc.y * bb.y; } }
                  KT[(((hd == 0 ? k : -k) + 31) * 16 + cp) * 16 + c] = acc; } }
            __syncthreads();
            { bf16* W1 = (bf16*)(ws + WS_W1) + (size_t)(l * S5_G + g) * 256 * 512;
              for (int i = F.tid; i < 128 * 64; i += NWAVES * 64) { const int kv = i & 63, pp = hd * 128 + (i >> 6), part = pp >> 6, p = pp & 63, s = kv >> 1, c0 = (kv & 1) * 8; const int e = hd == 0 ? 31 - s : s;
                  const f32x2 pw = POW[(hd * 33 + e) * 64 + p]; float o[8];
#pragma unroll
                  for (int j = 0; j < 8; ++j) { const f32x2 bb = BBl[(hd * 64 + p) * 16 + c0 + j]; o[j] = (part & 1) ? (pw.x * bb.y + pw.y * bb.x) : (pw.x * bb.x - pw.y * bb.y); }
                  v4u w; w.x = pkh(o[0], o[1]); w.y = pkh(o[2], o[3]); w.z = pkh(o[4], o[5]); w.w = pkh(o[6], o[7]); *(GAS v4u*)(W1 + (size_t)pp * 512 + kv * 8) = w; } }
            { bf16* MF = (bf16*)(ws + WS_MF) + (size_t)(l * S5_G + g) * 512 * 768;
              for (int i = F.tid; i < 512 * 96; i += NWAVES * 64) { const int kv = i % 96, r = i / 96, t = r >> 4, cp = r & 15; float o[8];
                  if (kv < 64) { const int s = kv >> 1, c0 = (kv & 1) * 8; if ((t >= s) != (hd == 0)) continue; const LAS float* kt = KT + ((t - s + 31) * 16 + cp) * 16 + c0;
#pragma unroll
                      for (int j = 0; j < 8; ++j) o[j] = kt[j]; }
                  else { const int pp0 = (kv - 64) * 8, part = pp0 >> 6, dir = part >> 1, e = dir == 0 ? t + 1 : 32 - t; if (dir != hd) continue;
#pragma unroll
                      for (int j = 0; j < 8; ++j) { const int p = (pp0 & 63) + j; const f32x2 cc = CCl[(dir * 16 + cp) * 64 + p], pw = POW[(dir * 33 + e) * 64 + p];
                          o[j] = (part & 1) ? -(cc.x * pw.y + cc.y * pw.x) : (cc.x * pw.x - cc.y * pw.y); } }
                  v4u w; w.x = pkh(o[0], o[1]); w.y = pkh(o[2], o[3]); w.z = pkh(o[4], o[5]); w.w = pkh(o[6], o[7]); *(GAS v4u*)(MF + (size_t)r * 768 + kv * 8) = w; } }
        }
        __syncthreads();
    }
    {
        LAS float* scr = (LAS float*)(F.lds + RING_OFF + F.wave * 16384);
        constexpr int I_FF = (D / 64) * (FF / 32);
        constexpr int I_W2 = (FF / 64) * (D / 32);
        constexpr int I_IN = (D / 64) * (NIN / 32);
        constexpr int I_OUT = (D / 64) * (D / 32);
        constexpr int I_GLU = (S5_W / 64) * (S5_W / 32);
        constexpr int PER_L = 4 * I_FF + 2 * I_W2 + I_IN + I_OUT + I_GLU;
        auto decode = [&](int it, TrItem& t) {
            const int l = it / PER_L; int r = it % PER_L;
            unsigned char* wl = ws + WS_W + (size_t)l * LW_STRIDE;
            int K; int mode = 0; t.ldw = 0;
            if (r < I_FF) { t.W = kargs()->in[I_F1W1] + (size_t)l * D * FF; K = D; t.N = FF; t.WT = (bf16*)(wl + LW_13A); mode = 1; }
            else if ((r -= I_FF) < I_FF) { t.W = kargs()->in[I_F1W3] + (size_t)l * D * FF; K = D; t.N = FF; t.WT = (bf16*)(wl + LW_13A); mode = 2; }
            else if ((r -= I_FF) < I_W2) { t.W = kargs()->in[I_F1W2] + (size_t)l * FF * D; K = FF; t.N = D; t.WT = (bf16*)(ws + WS_W2P) + (size_t)(l * 2 + 0) * D * LDG; t.ldw = LDG; }
            else if ((r -= I_W2) < I_FF) { t.W = kargs()->in[I_F2W1] + (size_t)l * D * FF; K = D; t.N = FF; t.WT = (bf16*)(wl + LW_13B); mode = 1; }
            else if ((r -= I_FF) < I_FF) { t.W = kargs()->in[I_F2W3] + (size_t)l * D * FF; K = D; t.N = FF; t.WT = (bf16*)(wl + LW_13B); mode = 2; }
            else if ((r -= I_FF) < I_W2) { t.W = kargs()->in[I_F2W2] + (size_t)l * FF * D; K = FF; t.N = D; t.WT = (bf16*)(ws + WS_W2P) + (size_t)(l * 2 + 1) * D * LDG; t.ldw = LDG; }
            else if ((r -= I_W2) < I_IN) { t.W = kargs()->in[I_WIN] + (size_t)l * D * NIN; K = D; t.N = NIN; t.WT = (bf16*)(wl + LW_IN); mode = 3; }
            else if ((r -= I_IN) < I_OUT) { t.W = kargs()->in[I_WOUT] + (size_t)l * D * D; K = D; t.N = D; t.WT = (bf16*)(wl + LW_OUT); }
            else { r -= I_OUT; t.W = kargs()->in[I_WGLU] + (size_t)l * S5_W * S5_W; K = S5_W; t.N = S5_W; t.WT = (bf16*)(wl + LW_GLU); }
            if (!t.ldw) t.ldw = K;
            const int nblk = t.N / 32, kb = r / nblk, nb = r % nblk; t.k0 = 64 * kb; t.n0 = 32 * nb;
            t.rowbase = t.n0;
            if (mode == 1 || mode == 2) t.rowbase = 256 * (t.n0 / 128) + (t.n0 % 128) + (mode == 2 ? 128 : 0);
            if (mode == 3 && t.n0 < 1024) { const int cl = t.n0 & 255, d0 = cl & 127; t.rowbase = (t.n0 & ~255) + 128 * (d0 >> 6) + 64 * (cl >> 7) + (d0 & 63); }
        };
        const int lane = lane_now();
        if (gw < DEPTH * PER_L) {
            constexpr int TOT = DEPTH * PER_L;
            TrItem ta, tb; float wa[32], wb[32]; decode(gw, ta); p0_tr_load(ta, wa, lane);
            for (int it = gw; ; it += 2 * NGW) {
                const int i1 = it + NGW; const bool has1 = i1 < TOT;
                decode(has1 ? i1 : it, tb); p0_tr_load(tb, wb, lane);
                p0_tr_store(ta, wa, scr, lane);
                if (!has1) break;
                const int i2 = it + 2 * NGW; const bool has2 = i2 < TOT;
                decode(has2 ? i2 : it, ta); p0_tr_load(ta, wa, lane);
                p0_tr_store(tb, wb, scr, lane);
                if (!has2) break;
            }
        }
        constexpr int PADV = (NINP - NIN) * D * 2 / 16;
        for (int i = gt; i < DEPTH * PADV; i += NGT) { const int l = i / PADV, r = i % PADV;
            *(GAS v4u*)(ws + WS_W + (size_t)l * LW_STRIDE + LW_IN + (size_t)NIN * D * 2 + (size_t)r * 16) = (v4u){0u, 0u, 0u, 0u}; }
    }
}

template <bool SRC16> __device__ __forceinline__ void norm_mod_phase(Frame& F, const void* srcv, const float* g, const float* shift, const float* scale, bf16* U, h16* h16out) {
    constexpr int R = 4;
    const int lane = lane_now();
    int gw = F.tv * NWAVES + F.wave; asm volatile("" : "+s"(gw)); const int NGW = F.T * NWAVES; const int m0 = F.hf * (M / F.nt);
    const bool contig = (NGW * 8 == M / F.nt);
    h16x4 raw[R][8];
    if constexpr (SRC16) { const int mb0 = m0 + gw * (contig ? 8 : R);
        if (contig || mb0 < m0 + M / F.nt) {
#pragma unroll
            for (int r = 0; r < R; ++r) { const GAS h16x4* xr = (const GAS h16x4*)((const h16*)srcv + (size_t)(mb0 + r) * D) + lane;
#pragma unroll
                for (int j = 0; j < 8; ++j) raw[r][j] = xr[64 * j]; } } }
    for (int k = 0, mb = m0 + gw * (contig ? 8 : R); contig ? k < 8 / R : mb < m0 + M / F.nt; ++k, mb += contig ? R : NGW * R) {
        const int b = mb / SEQ;
        f32x4 v[R][8]; float rstd[R];
        if constexpr (SRC16) {
#pragma unroll
            for (int r = 0; r < R; ++r)
#pragma unroll
                for (int j = 0; j < 8; ++j) v[r][j] = __builtin_convertvector(raw[r][j], f32x4);
            const int mbn = mb + (contig ? R : NGW * R);
            if (contig ? k + 1 < 8 / R : mbn < m0 + M / F.nt) {
#pragma unroll
                for (int r = 0; r < R; ++r) { const GAS h16x4* xr = (const GAS h16x4*)((const h16*)srcv + (size_t)(mbn + r) * D) + lane;
#pragma unroll
                    for (int j = 0; j < 8; ++j) raw[r][j] = xr[64 * j]; } } }
        else {
#pragma unroll
            for (int r = 0; r < R; ++r) { const GAS f32x4* xr = (const GAS f32x4*)((const float*)srcv + (size_t)(mb + r) * D) + lane; GAS h16x4* ho = (GAS h16x4*)(h16out + (size_t)(mb + r) * D) + lane;
#pragma unroll
                for (int j = 0; j < 8; ++j) { v[r][j] = xr[64 * j]; ho[64 * j] = __builtin_convertvector(v[r][j], h16x4); } } }
#pragma unroll
        for (int r = 0; r < R; ++r) { float s = 0.f;
#pragma unroll
            for (int j = 0; j < 8; ++j) s += (v[r][j].x * v[r][j].x + v[r][j].y * v[r][j].y) + (v[r][j].z * v[r][j].z + v[r][j].w * v[r][j].w);
            rstd[r] = __builtin_amdgcn_rsqf(wave_sum_l(s, lane) * (1.0f / D) + EPS); }
        const GAS f32x4* gp = (const GAS f32x4*)g + lane; const GAS f32x4* sh = (const GAS f32x4*)(shift + (size_t)b * MODW) + lane; const GAS f32x4* sc = (const GAS f32x4*)(scale + (size_t)b * MODW) + lane;
#pragma unroll
        for (int j = 0; j < 8; ++j) { const f32x4 gg = gp[64 * j], hh = sh[64 * j], cc = sc[64 * j] + 1.0f;
#pragma unroll
            for (int r = 0; r < R; ++r) { const f32x4 o = ((v[r][j] * rstd[r]) * gg) * cc + hh;
                ((GAS unsigned long long*)(U + (size_t)(mb + r) * D) + lane)[64 * j] = (unsigned long long)pkh(o.x, o.y) | ((unsigned long long)pkh(o.z, o.w) << 32); } }
    }
}
__device__ __forceinline__ void final_norm_phase(Frame& F, const h16* src, const float* g, float* out) {
    constexpr int R = 4;
    const int lane = lane_now();
    int gw = F.tv * NWAVES + F.wave; asm volatile("" : "+s"(gw)); const int NGW = F.T * NWAVES; const int m0 = F.hf * (M / F.nt);
    const bool contig = (NGW * 8 == M / F.nt);
    for (int k = 0, mb = m0 + gw * (contig ? 8 : R); contig ? k < 8 / R : mb < m0 + M / F.nt; ++k, mb += contig ? R : NGW * R) {
        h16x4 raw[R][8];
#pragma unroll
        for (int r = 0; r < R; ++r) { const GAS h16x4* xr = (const GAS h16x4*)(src + (size_t)(mb + r) * D) + lane;
#pragma unroll
            for (int j = 0; j < 8; ++j) raw[r][j] = xr[64 * j]; }
        const GAS f32x4* gp = (const GAS f32x4*)g + lane;
#pragma unroll
        for (int r = 0; r < R; ++r) { f32x4 v[8]; float s = 0.f;
#pragma unroll
            for (int j = 0; j < 8; ++j) { v[j] = __builtin_convertvector(raw[r][j], f32x4); s += (v[j].x * v[j].x + v[j].y * v[j].y) + (v[j].z * v[j].z + v[j].w * v[j].w); }
            const float rstd = __builtin_amdgcn_rsqf(wave_sum_l(s, lane) * (1.0f / D) + EPS);
            GAS f32x4* o = (GAS f32x4*)(out + (size_t)(mb + r) * D) + lane;
#pragma unroll
            for (int j = 0; j < 8; ++j) o[64 * j] = (v[j] * rstd) * gp[64 * j]; }
    }
}

#define LDS_BAR() do { asm volatile("s_waitcnt lgkmcnt(0)" ::: "memory"); __builtin_amdgcn_s_barrier(); asm volatile("" ::: "memory"); } while (0)
__device__ __forceinline__ void s5_scan_phase(Frame& F, int l) {
    const int lane = lane_now(); const int wave = F.wave;
    unsigned char* ws = (unsigned char*)kargs()->ws;
    const float* SC = (const float*)(ws + WS_SC); bf16* SUA = (bf16*)(ws + WS_SUA); const float* LT = (const float*)(ws + WS_S5LT);
    typedef float f32x2_ __attribute__((ext_vector_type(2)));
    LAS f32x2_* EX = (LAS f32x2_*)(F.lds + RING_OFF);
    const int nbt = BATCH / F.nt;
    for (int it = F.tv; it < S5_G * nbt * 2; it += F.T) {
        const int dir = it & 1, b = F.hf * nbt + (it >> 1) % nbt, g = (it >> 1) / nbt, p = lane;
        const int gi = ((l * 2 + dir) * S5_G + g) * S5_P + p; const float lr = LT[2 * gi], li = LT[2 * gi + 1];
        float sr[16], si[16];
#pragma unroll
        for (int t = 0; t < 16; ++t) { const int jj = 16 * wave + t, n = dir == 0 ? jj : 127 - jj; const size_t row = (size_t)g * 512 + b * 128 + n; sr[t] = SC[row * 256 + dir * 128 + p]; si[t] = SC[row * 256 + dir * 128 + 64 + p]; }
        float xr = 0.f, xi = 0.f;
#pragma unroll
        for (int t = 0; t < 16; ++t) { const float a = sr[t], c = si[t]; sr[t] = xr; si[t] = xi; const float nr = lr * xr - li * xi + a, ni = lr * xi + li * xr + c; xr = nr; xi = ni; }
        EX[wave * 64 + lane] = (f32x2_){xr, xi};
        float ar = lr, ai = li;
#pragma unroll
        for (int q = 0; q < 4; ++q) { const float t0 = ar * ar - ai * ai, t1 = 2.0f * ar * ai; ar = t0; ai = t1; }
        LDS_BAR();
        float cr = 0.f, ci = 0.f;
        for (int v = 0; v < wave; ++v) { const f32x2_ e = EX[v * 64 + lane]; const float nr = ar * cr - ai * ci + e.x, ni = ar * ci + ai * cr + e.y; cr = nr; ci = ni; }
        float pr = 1.0f, pi = 0.f;
#pragma unroll
        for (int t = 0; t < 16; ++t) { const int jj = 16 * wave + t, n = dir == 0 ? jj : 127 - jj; const size_t row = (size_t)g * 512 + b * 128 + n;
            SUA[row * 768 + 512 + dir * 128 + p] = (bf16)f2bf(sr[t] + pr * cr - pi * ci); SUA[row * 768 + 512 + dir * 128 + 64 + p] = (bf16)f2bf(si[t] + pr * ci + pi * cr);
            const float t0 = pr * lr - pi * li, t1 = pr * li + pi * lr; pr = t0; pi = t1; }
        LDS_BAR();
    }
}
typedef short s16x4 __attribute__((ext_vector_type(4)));
typedef float f32x2 __attribute__((ext_vector_type(2)));
template <int DK_, int DV_, bool SCALAR_> struct ChunkCfg { static constexpr int DK = DK_, DV = DV_, C = 64; static constexpr bool SCALAR = SCALAR_;
    static constexpr int PK = DK * 2 + 32, PV = DV * 2 + 32;
    static constexpr int T0 = 0, T1 = C * PK, T2 = 2 * C * PK, T3 = 3 * C * PK, VT = 4 * C * PK, BF = VT + C * PV, BB = BF + (SCALAR ? 0 : C * DK * 4), LR = BB + (SCALAR ? 0 : C * DK * 4),
                         WG = LR + (SCALAR ? 0 : C * 32 * 4), BG = WG + (SCALAR ? 0 : 2 * 16 * DK * 4), SEG = BG + (SCALAR ? 0 : 2 * DK * 4), PT = SEG + (SCALAR ? 0 : 2 * 8 * DK * 4), RED = PT + C * 160, END = RED + 8 * 64 * 8;
    static_assert(END <= RING_BYTES, "chunk LDS"); };
struct ChunkArgs { const bf16* proj; int qoff, koff, voff, goff; bf16* kv; float* dec; bf16* Y; int yoff; const float* wg; const float* bg; const float* lab; };
__device__ __forceinline__ bf16x8 tr_pair(const LAS unsigned char* p0, const LAS unsigned char* p1) {
    const s16x4 a = __builtin_amdgcn_ds_read_tr16_b64_v4i16((LAS s16x4*)p0), b = __builtin_amdgcn_ds_read_tr16_b64_v4i16((LAS s16x4*)p1);
    return __builtin_shufflevector(a, b, 0, 1, 2, 3, 4, 5, 6, 7); }
__device__ __forceinline__ float xlane_add(float v, int lane, int o) { return v + __int_as_float(__builtin_amdgcn_ds_bpermute((lane ^ o) << 2, __float_as_int(v))); }

typedef unsigned u32x2 __attribute__((ext_vector_type(2)));
__device__ __forceinline__ void unpack8(const v4u w, float (&f)[8]) {
#pragma unroll
    for (int j = 0; j < 4; ++j) { f[2 * j] = __uint_as_float(w[j] << 16); f[2 * j + 1] = __uint_as_float(w[j] & 0xffff0000u); } }
__device__ __forceinline__ v4u pack8(const float (&f)[8]) { v4u w; w.x = pkh(f[0], f[1]); w.y = pkh(f[2], f[3]); w.z = pkh(f[4], f[5]); w.w = pkh(f[6], f[7]); return w; }
template <class Cfg> __device__ __forceinline__ void chunk_decays(LAS unsigned char* lds, const ChunkArgs& A, int tid, int h, int& hprev, u32x2 lrw) {
    if constexpr (!Cfg::SCALAR) {
        constexpr int DK = Cfg::DK;
        LAS float* LRs = (LAS float*)(lds + Cfg::LR); LAS float* WGs = (LAS float*)(lds + Cfg::WG); LAS float* BGs = (LAS float*)(lds + Cfg::BG); LAS float* BFs = (LAS float*)(lds + Cfg::BF); LAS float* BBs = (LAS float*)(lds + Cfg::BB);
        if (h != hprev) { hprev = h;
            for (int i = tid; i < 2 * 16 * DK; i += 512) { const int d = i % DK, r = (i / DK) & 15, dir = i / (16 * DK); WGs[i] = A.wg[(dir * 16 + r) * 256 + h * DK + d]; }
            if (tid < 2 * DK) BGs[tid] = A.bg[(tid / DK) * 256 + h * DK + (tid % DK)]; }
        { LAS float* o = LRs + (tid >> 3) * 32 + (tid & 7) * 4; o[0] = __uint_as_float(lrw.x << 16); o[1] = __uint_as_float(lrw.x & 0xffff0000u); o[2] = __uint_as_float(lrw.y << 16); o[3] = __uint_as_float(lrw.y & 0xffff0000u); }
        LDS_BAR();
        { constexpr int PER = 64 * DK / 512;
          const int d = tid % DK, tb = tid / DK;
#pragma unroll
          for (int dir = 0; dir < 2; ++dir) { float wgr[16];
#pragma unroll
              for (int r = 0; r < 16; ++r) wgr[r] = WGs[(dir * 16 + r) * DK + d];
              const float bgv = BGs[dir * DK + d]; LAS float* o = dir == 0 ? BFs : BBs;
#pragma unroll
              for (int k = 0; k < PER; ++k) { const int t = tb + (512 / DK) * k; float s = bgv;
#pragma unroll
                  for (int r = 0; r < 16; r += 4) { const f32x4 lr4 = *(const LAS f32x4*)(LRs + t * 32 + dir * 16 + r); s += lr4[0] * wgr[r] + lr4[1] * wgr[r + 1] + lr4[2] * wgr[r + 2] + lr4[3] * wgr[r + 3]; }
                  o[t * DK + d] = (fminf(s, 0.f) - __logf(1.0f + __expf(-fabsf(s)))) * (1.0f / 16.0f); } } }
        LDS_BAR();
        LAS float* SG = (LAS float*)(lds + Cfg::SEG);
        for (int i = tid; i < 2 * 8 * DK; i += 512) { const int d = i % DK, sg = (i / DK) & 7, dir = i / (8 * DK); LAS float* a = (dir == 0 ? BFs : BBs); float run = 0.f;
            if (dir == 0) { for (int t = 8 * sg; t < 8 * sg + 8; ++t) { run += a[t * DK + d]; a[t * DK + d] = run; } }
            else { for (int t = 8 * sg + 7; t >= 8 * sg; --t) { run += a[t * DK + d]; a[t * DK + d] = run; } }
            SG[i] = run; }
        LDS_BAR();
        for (int i = tid; i < 2 * 8 * DK; i += 512) { const int d = i % DK, sg = (i / DK) & 7, dir = i / (8 * DK); LAS float* a = (dir == 0 ? BFs : BBs); float off = 0.f;
            if (dir == 0) { for (int g2 = 0; g2 < sg; ++g2) off += SG[(dir * 8 + g2) * DK + d]; } else { for (int g2 = sg + 1; g2 < 8; ++g2) off += SG[(dir * 8 + g2) * DK + d]; }
            for (int t = 8 * sg; t < 8 * sg + 8; ++t) a[t * DK + d] += off; }
        LDS_BAR();
    }
}
template <class Cfg, bool WITH_Q> struct ChunkIn {
    static constexpr int NQ = 64 * (Cfg::DK / 8) / 512, NV = 64 * (Cfg::DV / 8) / 512;
    v4u qw[NQ], kw[NQ], vw[NV]; f32x4 bf[NQ][2], bb[NQ][2], bfl[NQ][2], bb0[NQ][2];
    __device__ __forceinline__ void load(const ChunkArgs& A, int it, int tid) {
        const int h = it & 3, n = (it >> 2) & 63, b = it >> 8, tok0 = b * SEQ + n * 64;
#pragma unroll
        for (int u = 0; u < NQ; ++u) { const int i = tid + u * 512, t = i / (Cfg::DK / 8), dc = (i % (Cfg::DK / 8)) * 8; const bf16* rp = A.proj + (size_t)(tok0 + t) * NINP + h * Cfg::DK + dc;
            if (WITH_Q) qw[u] = *(const GAS v4u*)(rp + A.qoff); kw[u] = *(const GAS v4u*)(rp + A.koff);
            if constexpr (!Cfg::SCALAR) { const GAS f32x4* pf = (const GAS f32x4*)(A.lab + (size_t)(tok0 + t) * 512 + h * Cfg::DK + dc); bf[u][0] = pf[0]; bf[u][1] = pf[1]; bb[u][0] = pf[64]; bb[u][1] = pf[65];
                if (!WITH_Q) { const GAS f32x4* pl = (const GAS f32x4*)(A.lab + (size_t)(tok0 + 63) * 512 + h * Cfg::DK + dc); const GAS f32x4* p0 = (const GAS f32x4*)(A.lab + (size_t)tok0 * 512 + 256 + h * Cfg::DK + dc);
                    bfl[u][0] = pl[0]; bfl[u][1] = pl[1]; bb0[u][0] = p0[0]; bb0[u][1] = p0[1]; } } }
#pragma unroll
        for (int u = 0; u < NV; ++u) { const int i = tid + u * 512, t = i / (Cfg::DV / 8), c = (i % (Cfg::DV / 8)) * 8; vw[u] = *(const GAS v4u*)(A.proj + (size_t)(tok0 + t) * NINP + A.voff + h * Cfg::DV + c); }
    }
};

template <class Cfg> __device__ __forceinline__ void chunk_m1_phase(Frame& F, const ChunkArgs A, const int ngemm) {
    constexpr int DK = Cfg::DK, DV = Cfg::DV, PK = Cfg::PK, PV = Cfg::PV, DT = DK / 16, ETW = DV / 128;
    typedef ChunkIn<Cfg, false> In;
    const int tid = F.wave * 64 + lane_now();
    const int lane = tid & 63, wave = __builtin_amdgcn_readfirstlane(tid >> 6), fr = lane & 15, fq = lane >> 4;
    LAS unsigned char* lds = F.lds + RING_OFF;
    In in;
    const int ibase = F.hf * (1024 / F.nt), nit = 1024 / F.nt;
    const bool bal = (ngemm * 4 == F.T && nit == 4 * F.T); const int rk = bal ? F.tr : F.tv, step = F.T;
    const int cnt = bal ? (rk < ngemm ? 1 : 5) : (rk < nit ? (nit - rk + step - 1) / step : 0);
#define M1_ITEM(k) (ibase + ((bal && (k) == 4) ? (1 + (rk - ngemm) / ngemm) * step + (rk - ngemm) % ngemm : rk + (k) * step))
    if (cnt > 0) in.load(A, M1_ITEM(0), tid);
    for (int kk = 0; kk < cnt; ++kk) { const int it = M1_ITEM(kk);
        const int h = it & 3;
        const float lg = log1pf(-exp2f(-5.0f - (float)h));
        LDS_BAR();
#pragma unroll
        for (int u = 0; u < In::NQ; ++u) { const int i = tid + u * 512, t = i / (DK / 8), dc = (i % (DK / 8)) * 8; float kf[8], o0[8], o1[8]; unpack8(in.kw[u], kf);
#pragma unroll
            for (int j = 0; j < 8; ++j) { float ef, eb;
                if constexpr (Cfg::SCALAR) { ef = (float)(63 - t) * lg; eb = (float)t * lg; } else { ef = in.bfl[u][j >> 2][j & 3] - in.bf[u][j >> 2][j & 3]; eb = in.bb0[u][j >> 2][j & 3] - in.bb[u][j >> 2][j & 3]; }
                o0[j] = kf[j] * __expf(ef); o1[j] = kf[j] * __expf(eb); }
            *(LAS v4u*)(lds + Cfg::T0 + t * PK + dc * 2) = pack8(o0); *(LAS v4u*)(lds + Cfg::T1 + t * PK + dc * 2) = pack8(o1); }
#pragma unroll
        for (int u = 0; u < In::NV; ++u) { const int i = tid + u * 512, t = i / (DV / 8), c = (i % (DV / 8)) * 8; *(LAS v4u*)(lds + Cfg::VT + t * PV + c * 2) = in.vw[u]; }
        if (tid < 2 * DK) { const int dir = tid / DK, d = tid % DK; float e;
            if constexpr (Cfg::SCALAR) e = 64.0f * lg; else { const int tok0_ = (it >> 8) * SEQ + ((it >> 2) & 63) * 64; e = A.lab[(size_t)(tok0_ + (dir == 0 ? 63 : 0)) * 512 + dir * 256 + h * DK + d]; }
            A.dec[((size_t)it * 2 + dir) * DK + d] = __expf(e); }
        if (kk + 1 < cnt) in.load(A, M1_ITEM(kk + 1), tid);
        LDS_BAR();
#pragma unroll
        for (int dir = 0; dir < 2; ++dir) {
            const LAS unsigned char* KS = lds + (dir == 0 ? Cfg::T0 : Cfg::T1);
#pragma unroll
            for (int x = 0; x < ETW; ++x) { const int et = wave * ETW + x;
                bf16x8 vf[2];
#pragma unroll
                for (int kp = 0; kp < 2; ++kp) { const LAS unsigned char* p = lds + Cfg::VT + (32 * kp + 4 * fq + (fr >> 2)) * PV + (16 * et + 4 * (fr & 3)) * 2; vf[kp] = tr_pair(p, p + 16 * PV); }
#pragma unroll
                for (int dt = 0; dt < DT; ++dt) { f32x4 acc = (f32x4){0.f, 0.f, 0.f, 0.f};
#pragma unroll
                    for (int kp = 0; kp < 2; ++kp) { const LAS unsigned char* p = KS + (32 * kp + 4 * fq + (fr >> 2)) * PK + (16 * dt + 4 * (fr & 3)) * 2; const bf16x8 kf = tr_pair(p, p + 16 * PK);
                        acc = __builtin_amdgcn_mfma_f32_16x16x32_bf16(kf, vf[kp], acc, 0, 0, 0); }
                    u32x2 w; w.x = pkh(acc[0], acc[1]); w.y = pkh(acc[2], acc[3]);
                    *(GAS u32x2*)(A.kv + (((size_t)it * 2 + dir) * DV + 16 * et + fr) * DK + 16 * dt + 4 * fq) = w; } }
        }
    }
    LDS_BAR();
}
#undef M1_ITEM
__device__ __forceinline__ void ret_scan_phase(Frame& F, const ChunkArgs A) {
    constexpr int DK = 128, DV = 256, DC = DK / 8, NCH = 32, TOTAL = 16 * 2 * DV * DC;
    const int tid = F.wave * 64 + lane_now();
    const int gt = (F.tv * NWAVES * 64) + tid, NGT = F.T * NWAVES * 64;
    for (int idx = gt; idx < TOTAL / F.nt; idx += NGT) {
        const int dch = idx % DC, e = (idx / DC) % DV, r = idx / (DC * DV), dir = r & 1, h = (r >> 1) & 3, b = F.hf * (BATCH / F.nt) + (r >> 3);
        const float lgh = h == 0 ? -0.031748698314580298f : h == 1 ? -0.015748356968139168f : h == 2 ? -0.007843177461025893f : -0.003913899321136329f; const float dec = __expf(128.0f * lgh);
        float S[8];
#pragma unroll
        for (int j = 0; j < 8; ++j) S[j] = 0.f;
        for (int s0 = 0; s0 < NCH; s0 += 16) {
            v4u kvw[16];
#pragma unroll
            for (int u = 0; u < 16; ++u) { const int n = dir == 0 ? s0 + u : NCH - 1 - s0 - u; const size_t item = (size_t)(b * NCH + n) * 4 + h; kvw[u] = *(const GAS v4u*)(A.kv + ((item * 2 + dir) * DV + e) * DK + dch * 8); }
#pragma unroll
            for (int u = 0; u < 16; ++u) { const int n = dir == 0 ? s0 + u : NCH - 1 - s0 - u; const size_t item = (size_t)(b * NCH + n) * 4 + h;
                *(GAS v4u*)(A.kv + ((item * 2 + dir) * DV + e) * DK + dch * 8) = pack8(S);
                float kf[8]; unpack8(kvw[u], kf);
#pragma unroll
                for (int j = 0; j < 8; ++j) S[j] = dec * S[j] + kf[j]; }
        }
    }
}
__device__ __forceinline__ void gla_scan_phase(Frame& F, const ChunkArgs A) {
    constexpr int DK = 64, DV = 128, DC = DK / 2, NCH = 64, TOTAL = 16 * 2 * DV * DC;
    const int tid = F.wave * 64 + lane_now();
    const int gt = (F.tv * NWAVES * 64) + tid, NGT = F.T * NWAVES * 64;
    for (int idx = gt; idx < TOTAL / F.nt; idx += NGT) {
        const int dch = idx % DC, e = (idx / DC) % DV, r = idx / (DC * DV), dir = r & 1, h = (r >> 1) & 3, b = F.hf * (BATCH / F.nt) + (r >> 3);
        float S0 = 0.f, S1 = 0.f;
        for (int s0 = 0; s0 < NCH; s0 += 16) {
            unsigned kvw[16]; f32x2 dv[16];
#pragma unroll
            for (int u = 0; u < 16; ++u) { const int n = dir == 0 ? s0 + u : NCH - 1 - s0 - u; const size_t item = (size_t)(b * NCH + n) * 4 + h;
                kvw[u] = *(const GAS unsigned*)(A.kv + ((item * 2 + dir) * DV + e) * DK + dch * 2); dv[u] = *(const GAS f32x2*)(A.dec + (item * 2 + dir) * DK + dch * 2); }
#pragma unroll
            for (int u = 0; u < 16; ++u) { const int n = dir == 0 ? s0 + u : NCH - 1 - s0 - u; const size_t item = (size_t)(b * NCH + n) * 4 + h;
                *(GAS unsigned*)(A.kv + ((item * 2 + dir) * DV + e) * DK + dch * 2) = pkh(S0, S1);
                S0 = dv[u].x * S0 + __uint_as_float(kvw[u] << 16); S1 = dv[u].y * S1 + __uint_as_float(kvw[u] & 0xffff0000u); }
        }
    }
}
template <class Cfg, bool LAYERNORM> __device__ __forceinline__ void chunk_m2_phase(Frame& F, const ChunkArgs A, const int ngemm) {
    constexpr int DK = Cfg::DK, DV = Cfg::DV, PK = Cfg::PK, PV = Cfg::PV, KS = DK / 32, EW = DV / 128, PP = 160;
    typedef ChunkIn<Cfg, true> In;
    const int tid = F.wave * 64 + lane_now();
    const int lane = tid & 63, wave = __builtin_amdgcn_readfirstlane(tid >> 6), fr = lane & 15, fq = lane >> 4;
    LAS unsigned char* lds = F.lds + RING_OFF;
    In in;
    const int ibase = F.hf * (1024 / F.nt), nit = 1024 / F.nt;
    const bool bal = (ngemm * 2 == F.T && nit == 4 * F.T); const int rk = bal ? F.tr : F.tv, step = F.T;
    const int cnt = bal ? (rk < ngemm ? 3 : 5) : (rk < nit ? (nit - rk + step - 1) / step : 0);
#define M2_ITEM(k) (ibase + ((bal && (k) == 4) ? 3 * step + (rk - ngemm) : rk + (k) * step))
    if (cnt > 0) in.load(A, M2_ITEM(0), tid);
    for (int kk = 0; kk < cnt; ++kk) { const int it = M2_ITEM(kk);
        const int h = it & 3, n = (it >> 2) & 63, b = it >> 8, tok0 = b * SEQ + n * 64;
        const float lg = log1pf(-exp2f(-5.0f - (float)h));
        bf16x8 sF[EW][KS], sB[EW][KS];
#pragma unroll
        for (int x = 0; x < EW; ++x) { const int et = wave * EW + x;
            const bf16* sfp = A.kv + (((size_t)it * 2 + 0) * DV + 16 * et + fr) * DK + 8 * fq; const bf16* sbp = A.kv + (((size_t)it * 2 + 1) * DV + 16 * et + fr) * DK + 8 * fq;
#pragma unroll
            for (int ks = 0; ks < KS; ++ks) { sF[x][ks] = *(const GAS bf16x8*)(sfp + 32 * ks); sB[x][ks] = *(const GAS bf16x8*)(sbp + 32 * ks); } }
        LDS_BAR();
#pragma unroll
        for (int u = 0; u < In::NQ; ++u) { const int i = tid + u * 512, t = i / (DK / 8), dc = (i % (DK / 8)) * 8;
            float qf[8], kf[8], o0[8], o1[8], o2[8], o3[8]; unpack8(in.qw[u], qf); unpack8(in.kw[u], kf);
#pragma unroll
            for (int j = 0; j < 8; ++j) { float bfv, bbv;
                if constexpr (Cfg::SCALAR) { bfv = (float)(t + 1) * lg; bbv = (float)(64 - t) * lg; } else { bfv = in.bf[u][j >> 2][j & 3]; bbv = in.bb[u][j >> 2][j & 3]; }
                o0[j] = qf[j] * __expf(bfv); o1[j] = qf[j] * __expf(bbv); o2[j] = kf[j] * __expf(-bfv); o3[j] = kf[j] * __expf(-bbv); }
            *(LAS v4u*)(lds + Cfg::T0 + t * PK + dc * 2) = pack8(o0); *(LAS v4u*)(lds + Cfg::T1 + t * PK + dc * 2) = pack8(o1);
            *(LAS v4u*)(lds + Cfg::T2 + t * PK + dc * 2) = pack8(o2); *(LAS v4u*)(lds + Cfg::T3 + t * PK + dc * 2) = pack8(o3); }
#pragma unroll
        for (int u = 0; u < In::NV; ++u) { const int i = tid + u * 512, t = i / (DV / 8), c = (i % (DV / 8)) * 8; *(LAS v4u*)(lds + Cfg::VT + t * PV + c * 2) = in.vw[u]; }
        if (kk + 1 < cnt) in.load(A, M2_ITEM(kk + 1), tid);
        u32x2 gw[EW][4];
#pragma unroll
        for (int itile = 0; itile < 4; ++itile)
#pragma unroll
            for (int x = 0; x < EW; ++x) gw[x][itile] = *(const GAS u32x2*)(A.proj + (size_t)(tok0 + 16 * itile + fr) * NINP + A.goff + h * DV + 16 * (wave * EW + x) + 4 * fq);
        LDS_BAR();
#pragma unroll
        for (int u = 0; u < 2; ++u) { const int pr = wave * 2 + u, jt = pr & 3, itile = pr >> 2; f32x4 sf = (f32x4){0.f, 0.f, 0.f, 0.f}, sb = (f32x4){0.f, 0.f, 0.f, 0.f};
#pragma unroll
            for (int ks = 0; ks < KS; ++ks) {
                const bf16x8 kF = *(const LAS bf16x8*)(lds + Cfg::T2 + (16 * jt + fr) * PK + (32 * ks + 8 * fq) * 2), kB = *(const LAS bf16x8*)(lds + Cfg::T3 + (16 * jt + fr) * PK + (32 * ks + 8 * fq) * 2);
                const bf16x8 qF = *(const LAS bf16x8*)(lds + Cfg::T0 + (16 * itile + fr) * PK + (32 * ks + 8 * fq) * 2), qB = *(const LAS bf16x8*)(lds + Cfg::T1 + (16 * itile + fr) * PK + (32 * ks + 8 * fq) * 2);
                sf = __builtin_amdgcn_mfma_f32_16x16x32_bf16(kF, qF, sf, 0, 0, 0); sb = __builtin_amdgcn_mfma_f32_16x16x32_bf16(kB, qB, sb, 0, 0, 0); }
            float pv[4];
#pragma unroll
            for (int ii = 0; ii < 4; ++ii) { const int j = 16 * jt + 4 * fq + ii, i = 16 * itile + fr; pv[ii] = (j <= i) ? sf[ii] : sb[ii]; }
            u32x2 w; w.x = pkh(pv[0], pv[1]); w.y = pkh(pv[2], pv[3]);
            *(LAS u32x2*)(lds + Cfg::PT + (16 * itile + fr) * PP + (32 * (jt >> 1) + 8 * fq + 4 * (jt & 1)) * 2) = w; }
        LDS_BAR();
        bf16x8 vf[EW][2];
#pragma unroll
        for (int x = 0; x < EW; ++x)
#pragma unroll
            for (int kp = 0; kp < 2; ++kp) { const LAS unsigned char* p = lds + Cfg::VT + (32 * kp + 4 * fq + (fr >> 2)) * PV + (16 * (wave * EW + x) + 4 * (fr & 3)) * 2; vf[x][kp] = tr_pair(p, p + 16 * PV); }
        f32x4 O[EW][4];
#pragma unroll
        for (int itile = 0; itile < 4; ++itile) {
#pragma unroll
            for (int x = 0; x < EW; ++x) O[x][itile] = (f32x4){0.f, 0.f, 0.f, 0.f};
#pragma unroll
            for (int kp = 0; kp < 2; ++kp) { const bf16x8 pf = *(const LAS bf16x8*)(lds + Cfg::PT + (16 * itile + fr) * PP + (32 * kp + 8 * fq) * 2);
#pragma unroll
                for (int x = 0; x < EW; ++x) O[x][itile] = __builtin_amdgcn_mfma_f32_16x16x32_bf16(vf[x][kp], pf, O[x][itile], 0, 0, 0); }
#pragma unroll
            for (int ks = 0; ks < KS; ++ks) { const bf16x8 qF = *(const LAS bf16x8*)(lds + Cfg::T0 + (16 * itile + fr) * PK + (32 * ks + 8 * fq) * 2), qB = *(const LAS bf16x8*)(lds + Cfg::T1 + (16 * itile + fr) * PK + (32 * ks + 8 * fq) * 2);
#pragma unroll
                for (int x = 0; x < EW; ++x) { O[x][itile] = __builtin_amdgcn_mfma_f32_16x16x32_bf16(sF[x][ks], qF, O[x][itile], 0, 0, 0); O[x][itile] = __builtin_amdgcn_mfma_f32_16x16x32_bf16(sB[x][ks], qB, O[x][itile], 0, 0, 0); } }
        }
        LAS f32x2* RED = (LAS f32x2*)(lds + Cfg::RED);
#pragma unroll
        for (int itile = 0; itile < 4; ++itile) { float s1 = 0.f, s2 = 0.f;
#pragma unroll
            for (int x = 0; x < EW; ++x)
#pragma unroll
                for (int ii = 0; ii < 4; ++ii) { s1 += O[x][itile][ii]; s2 += O[x][itile][ii] * O[x][itile][ii]; }
            s1 = xlane_add(s1, lane, 16); s1 = xlane_add(s1, lane, 32); s2 = xlane_add(s2, lane, 16); s2 = xlane_add(s2, lane, 32);
            if (fq == 0) RED[wave * 64 + 16 * itile + fr] = (f32x2){s1, s2}; }
        LDS_BAR();
#pragma unroll
        for (int itile = 0; itile < 4; ++itile) { float t1 = 0.f, t2 = 0.f;
#pragma unroll
            for (int w = 0; w < 8; ++w) { const f32x2 r = RED[w * 64 + 16 * itile + fr]; t1 += r.x; t2 += r.y; }
            const float m1 = t1 * (1.0f / DV), m2 = t2 * (1.0f / DV);
            const float mean = LAYERNORM ? m1 : 0.f, rstd = __builtin_amdgcn_rsqf((LAYERNORM ? m2 - m1 * m1 : m2) + EPS);
            const size_t tok = (size_t)(tok0 + 16 * itile + fr);
#pragma unroll
            for (int x = 0; x < EW; ++x) { const int e = 16 * (wave * EW + x) + 4 * fq; const u32x2 g4 = gw[x][itile];
                const float g0 = __uint_as_float(g4.x << 16), g1 = __uint_as_float(g4.x & 0xffff0000u), g2 = __uint_as_float(g4.y << 16), g3 = __uint_as_float(g4.y & 0xffff0000u);
                u32x2 w; w.x = pkh(g0 * __builtin_amdgcn_rcpf(1.0f + __expf(-g0)) * (O[x][itile][0] - mean) * rstd, g1 * __builtin_amdgcn_rcpf(1.0f + __expf(-g1)) * (O[x][itile][1] - mean) * rstd);
                w.y = pkh(g2 * __builtin_amdgcn_rcpf(1.0f + __expf(-g2)) * (O[x][itile][2] - mean) * rstd, g3 * __builtin_amdgcn_rcpf(1.0f + __expf(-g3)) * (O[x][itile][3] - mean) * rstd);
                *(GAS u32x2*)(A.Y + tok * D + A.yoff + h * DV + e) = w; } }
    }
    LDS_BAR();
}
#undef M2_ITEM
namespace r128 { constexpr int C = 128, DK = 128, DV = 256, PK = DK * 2 + 32, PV = DV * 2 + 32, T0 = 0, T1 = C * PK, VT = 2 * C * PK, RED = VT + C * PV, END = RED + 8 * 128 * 8;
    static_assert(END <= CHUNK_LDS_MAX, "retention LDS"); }
__device__ __forceinline__ float ret_lg(int h) { return h == 0 ? -0.031748698314580298f : h == 1 ? -0.015748356968139168f : h == 2 ? -0.007843177461025893f : -0.003913899321136329f; }
__device__ __forceinline__ void ret_m1_phase(Frame& F, const ChunkArgs A) {
    using namespace r128;
    const int wave = F.wave;
    LAS unsigned char* lds = F.lds + RING_OFF;
    v4u kw[4], vw[8]; bool pre = false;
    for (int it = F.hf * (512 / F.nt) + F.tv; it < (F.hf + 1) * (512 / F.nt); it += F.T) {
        const int tid = wave * 64 + lane_now(), lane = tid & 63, fr = lane & 15, fq = lane >> 4;
        const int h = it & 3, n = (it >> 2) & 31, b = it >> 7, tok0 = b * SEQ + n * C; const float lg = ret_lg(h);
        if (!pre) {
#pragma unroll
            for (int u = 0; u < 4; ++u) { const int i = tid + u * 512, t = i >> 4, dc = (i & 15) * 8; kw[u] = *(const GAS v4u*)(A.proj + (size_t)(tok0 + t) * NINP + A.koff + h * DK + dc); }
#pragma unroll
            for (int u = 0; u < 8; ++u) { const int i = tid + u * 512, t = i >> 5, c = (i & 31) * 8; vw[u] = *(const GAS v4u*)(A.proj + (size_t)(tok0 + t) * NINP + A.voff + h * DV + c); } }
        LDS_BAR();
#pragma unroll
        for (int u = 0; u < 4; ++u) { const int i = tid + u * 512, t = i >> 4, dc = (i & 15) * 8; float kf[8], o0[8], o1[8]; unpack8(kw[u], kf);
            const float sf = __expf((float)(C - 1 - t) * lg), sb = __expf((float)t * lg);
#pragma unroll
            for (int j = 0; j < 8; ++j) { o0[j] = kf[j] * sf; o1[j] = kf[j] * sb; }
            *(LAS v4u*)(lds + T0 + t * PK + dc * 2) = pack8(o0); *(LAS v4u*)(lds + T1 + t * PK + dc * 2) = pack8(o1); }
#pragma unroll
        for (int u = 0; u < 8; ++u) { const int i = tid + u * 512, t = i >> 5, c = (i & 31) * 8; *(LAS v4u*)(lds + VT + t * PV + c * 2) = vw[u]; }
        if (tid < 2 * DK) A.dec[((size_t)it * 2 + (tid >> 7)) * DK + (tid & 127)] = __expf((float)C * lg);
        pre = (it + F.T < (F.hf + 1) * (512 / F.nt));
        if (pre) { const int it2 = it + F.T, h2 = it2 & 3, tok2 = (it2 >> 7) * SEQ + ((it2 >> 2) & 31) * C;
#pragma unroll
            for (int u = 0; u < 4; ++u) { const int i = tid + u * 512, t = i >> 4, dc = (i & 15) * 8; kw[u] = *(const GAS v4u*)(A.proj + (size_t)(tok2 + t) * NINP + A.koff + h2 * DK + dc); }
#pragma unroll
            for (int u = 0; u < 8; ++u) { const int i = tid + u * 512, t = i >> 5, c = (i & 31) * 8; vw[u] = *(const GAS v4u*)(A.proj + (size_t)(tok2 + t) * NINP + A.voff + h2 * DV + c); } }
        LDS_BAR();
        bf16x8 vf[2][4];
#pragma unroll
        for (int x = 0; x < 2; ++x)
#pragma unroll
            for (int kp = 0; kp < 4; ++kp) { const LAS unsigned char* p = lds + VT + (32 * kp + 4 * fq + (fr >> 2)) * PV + (16 * (wave * 2 + x) + 4 * (fr & 3)) * 2; vf[x][kp] = tr_pair(p, p + 16 * PV); }
#pragma unroll
        for (int dir = 0; dir < 2; ++dir) { const LAS unsigned char* KS = lds + (dir == 0 ? T0 : T1);
#pragma unroll
            for (int dt = 0; dt < 8; ++dt) { f32x4 acc0 = (f32x4){0.f, 0.f, 0.f, 0.f}, acc1 = (f32x4){0.f, 0.f, 0.f, 0.f};
#pragma unroll
                for (int kp = 0; kp < 4; ++kp) { const LAS unsigned char* p = KS + (32 * kp + 4 * fq + (fr >> 2)) * PK + (16 * dt + 4 * (fr & 3)) * 2; const bf16x8 kf = tr_pair(p, p + 16 * PK);
                    acc0 = __builtin_amdgcn_mfma_f32_16x16x32_bf16(kf, vf[0][kp], acc0, 0, 0, 0); acc1 = __builtin_amdgcn_mfma_f32_16x16x32_bf16(kf, vf[1][kp], acc1, 0, 0, 0); }
                u32x2 w0; w0.x = pkh(acc0[0], acc0[1]); w0.y = pkh(acc0[2], acc0[3]); u32x2 w1; w1.x = pkh(acc1[0], acc1[1]); w1.y = pkh(acc1[2], acc1[3]);
                *(GAS u32x2*)(A.kv + (((size_t)it * 2 + dir) * DV + 16 * (wave * 2 + 0) + fr) * DK + 16 * dt + 4 * fq) = w0;
                *(GAS u32x2*)(A.kv + (((size_t)it * 2 + dir) * DV + 16 * (wave * 2 + 1) + fr) * DK + 16 * dt + 4 * fq) = w1; } }
    }
    LDS_BAR();
}
__device__ __forceinline__ void ret_m2_phase(Frame& F, const ChunkArgs A) {
    using namespace r128;
    const int wave = F.wave;
    LAS unsigned char* lds = F.lds + RING_OFF;
    for (int it = F.hf * (512 / F.nt) + F.tv; it < (F.hf + 1) * (512 / F.nt); it += F.T) {
        const int tid = wave * 64 + lane_now(), lane = tid & 63, fr = lane & 15, fq = lane >> 4;
        const int h = it & 3, n = (it >> 2) & 31, b = it >> 7, tok0 = b * SEQ + n * C; const float lg = ret_lg(h), l2g = lg * 1.4426950408889634f;
        { v4u qw[4], kw[4], vw[8];
#pragma unroll
          for (int u = 0; u < 4; ++u) { const int i = tid + u * 512, t = i >> 4, dc = (i & 15) * 8; const bf16* rp = A.proj + (size_t)(tok0 + t) * NINP + h * DK + dc; qw[u] = *(const GAS v4u*)(rp + A.qoff); kw[u] = *(const GAS v4u*)(rp + A.koff); }
#pragma unroll
          for (int u = 0; u < 8; ++u) { const int i = tid + u * 512, t = i >> 5, c = (i & 31) * 8; vw[u] = *(const GAS v4u*)(A.proj + (size_t)(tok0 + t) * NINP + A.voff + h * DV + c); }
          LDS_BAR();
#pragma unroll
          for (int u = 0; u < 4; ++u) { const int i = tid + u * 512, t = i >> 4, dc = (i & 15) * 8; *(LAS v4u*)(lds + T0 + t * PK + dc * 2) = qw[u]; *(LAS v4u*)(lds + T1 + t * PK + dc * 2) = kw[u]; }
#pragma unroll
          for (int u = 0; u < 8; ++u) { const int i = tid + u * 512, t = i >> 5, c = (i & 31) * 8; *(LAS v4u*)(lds + VT + t * PV + c * 2) = vw[u]; } }
        LDS_BAR();
        u32x2 pw[8];
        { bf16x8 qf[4];
#pragma unroll
          for (int ks = 0; ks < 4; ++ks) qf[ks] = *(const LAS bf16x8*)(lds + T0 + (16 * wave + fr) * PK + (32 * ks + 8 * fq) * 2);
#pragma unroll
          for (int jt = 0; jt < 8; ++jt) { f32x4 st = (f32x4){0.f, 0.f, 0.f, 0.f};
#pragma unroll
              for (int ks = 0; ks < 4; ++ks) { const bf16x8 kf = *(const LAS bf16x8*)(lds + T1 + (16 * jt + fr) * PK + (32 * ks + 8 * fq) * 2); st = __builtin_amdgcn_mfma_f32_16x16x32_bf16(kf, qf[ks], st, 0, 0, 0); }
              float pv[4];
#pragma unroll
              for (int ii = 0; ii < 4; ++ii) { const int dj = 16 * jt + 4 * fq + ii - (16 * wave + fr); pv[ii] = st[ii] * __builtin_amdgcn_exp2f((float)(dj < 0 ? -dj : dj) * l2g); }
              pw[jt].x = pkh(pv[0], pv[1]); pw[jt].y = pkh(pv[2], pv[3]); } }
        bf16x8 sF[2][4], sB[2][4];
#pragma unroll
        for (int x = 0; x < 2; ++x) { const int et = wave * 2 + x;
            const bf16* sfp = A.kv + (((size_t)it * 2 + 0) * DV + 16 * et + fr) * DK + 8 * fq; const bf16* sbp = A.kv + (((size_t)it * 2 + 1) * DV + 16 * et + fr) * DK + 8 * fq;
#pragma unroll
            for (int ks = 0; ks < 4; ++ks) { sF[x][ks] = *(const GAS bf16x8*)(sfp + 32 * ks); sB[x][ks] = *(const GAS bf16x8*)(sbp + 32 * ks); } }
        LDS_BAR();
#pragma unroll
        for (int jt = 0; jt < 8; ++jt) *(LAS u32x2*)(lds + T1 + (16 * wave + fr) * PK + (32 * (jt >> 1) + 8 * fq + 4 * (jt & 1)) * 2) = pw[jt];
        LDS_BAR();
        f32x4 O[2][8];
        { bf16x8 vf[2][4];
#pragma unroll
          for (int x = 0; x < 2; ++x)
#pragma unroll
            for (int kp = 0; kp < 4; ++kp) { const LAS unsigned char* p = lds + VT + (32 * kp + 4 * fq + (fr >> 2)) * PV + (16 * (wave * 2 + x) + 4 * (fr & 3)) * 2; vf[x][kp] = tr_pair(p, p + 16 * PV); }
#pragma unroll
          for (int itile = 0; itile < 8; ++itile) {
#pragma unroll
            for (int x = 0; x < 2; ++x) O[x][itile] = (f32x4){0.f, 0.f, 0.f, 0.f};
#pragma unroll
            for (int kp = 0; kp < 4; ++kp) { const bf16x8 pf = *(const LAS bf16x8*)(lds + T1 + (16 * itile + fr) * PK + (32 * kp + 8 * fq) * 2);
#pragma unroll
                for (int x = 0; x < 2; ++x) O[x][itile] = __builtin_amdgcn_mfma_f32_16x16x32_bf16(vf[x][kp], pf, O[x][itile], 0, 0, 0); }
            asm volatile("" ::: "memory"); } }
#pragma unroll
        for (int itile = 0; itile < 8; ++itile) { f32x4 Tf[2], Tb[2];
#pragma unroll
            for (int x = 0; x < 2; ++x) { Tf[x] = (f32x4){0.f, 0.f, 0.f, 0.f}; Tb[x] = (f32x4){0.f, 0.f, 0.f, 0.f}; }
#pragma unroll
            for (int ks = 0; ks < 4; ++ks) { const bf16x8 qf = *(const LAS bf16x8*)(lds + T0 + (16 * itile + fr) * PK + (32 * ks + 8 * fq) * 2);
#pragma unroll
                for (int x = 0; x < 2; ++x) { Tf[x] = __builtin_amdgcn_mfma_f32_16x16x32_bf16(sF[x][ks], qf, Tf[x], 0, 0, 0); Tb[x] = __builtin_amdgcn_mfma_f32_16x16x32_bf16(sB[x][ks], qf, Tb[x], 0, 0, 0); } }
            const int i = 16 * itile + fr; const float cf = __builtin_amdgcn_exp2f((float)(i + 1) * l2g), cb = __builtin_amdgcn_exp2f((float)(C - i) * l2g);
#pragma unroll
            for (int x = 0; x < 2; ++x) O[x][itile] = O[x][itile] + Tf[x] * cf + Tb[x] * cb;
            asm volatile("" ::: "memory"); }
        u32x2 gq[2][8];
#pragma unroll
        for (int itile = 0; itile < 8; ++itile)
#pragma unroll
            for (int x = 0; x < 2; ++x) gq[x][itile] = *(const GAS u32x2*)(A.proj + (size_t)(tok0 + 16 * itile + fr) * NINP + A.goff + h * DV + 16 * (wave * 2 + x) + 4 * fq);
        LAS f32x2* REDp = (LAS f32x2*)(lds + RED);
#pragma unroll
        for (int itile = 0; itile < 8; ++itile) { float s1 = 0.f, s2 = 0.f;
#pragma unroll
            for (int x = 0; x < 2; ++x)
#pragma unroll
                for (int ii = 0; ii < 4; ++ii) { s1 += O[x][itile][ii]; s2 += O[x][itile][ii] * O[x][itile][ii]; }
            s1 = xlane_add(s1, lane, 16); s1 = xlane_add(s1, lane, 32); s2 = xlane_add(s2, lane, 16); s2 = xlane_add(s2, lane, 32);
            if (fq == 0) REDp[wave * 128 + 16 * itile + fr] = (f32x2){s1, s2}; }
        LDS_BAR();
#pragma unroll
        for (int itile = 0; itile < 8; ++itile) { float t1 = 0.f, t2 = 0.f;
#pragma unroll
            for (int w = 0; w < 8; ++w) { const f32x2 r = REDp[w * 128 + 16 * itile + fr]; t1 += r.x; t2 += r.y; }
            const float mean = t1 * (1.0f / DV), rstd = __builtin_amdgcn_rsqf(t2 * (1.0f / DV) - mean * mean + EPS);
            const size_t tok = (size_t)(tok0 + 16 * itile + fr);
#pragma unroll
            for (int x = 0; x < 2; ++x) { const int e = 16 * (wave * 2 + x) + 4 * fq; const u32x2 g4 = gq[x][itile];
                const float g0 = __uint_as_float(g4.x << 16), g1 = __uint_as_float(g4.x & 0xffff0000u), g2 = __uint_as_float(g4.y << 16), g3 = __uint_as_float(g4.y & 0xffff0000u);
                u32x2 w; w.x = pkh(g0 * __builtin_amdgcn_rcpf(1.0f + __expf(-g0)) * (O[x][itile][0] - mean) * rstd, g1 * __builtin_amdgcn_rcpf(1.0f + __expf(-g1)) * (O[x][itile][1] - mean) * rstd);
                w.y = pkh(g2 * __builtin_amdgcn_rcpf(1.0f + __expf(-g2)) * (O[x][itile][2] - mean) * rstd, g3 * __builtin_amdgcn_rcpf(1.0f + __expf(-g3)) * (O[x][itile][3] - mean) * rstd);
                *(GAS u32x2*)(A.Y + tok * D + A.yoff + h * DV + e) = w; }
            asm volatile("" ::: "memory"); }
    }
    LDS_BAR();
}
typedef ChunkCfg<128, 256, true> RetCfg;
typedef ChunkCfg<64, 128, false> GlaCfg;

__device__ __forceinline__ void lr_phase(Frame& F, const bf16* U, const bf16* Bt, const float* wg, const float* bg, float* lab) {
    const int tid = F.wave * 64 + lane_now();
    const int lane = tid & 63, wave = __builtin_amdgcn_readfirstlane(tid >> 6), fr = lane & 15, fq = lane >> 4;
    LAS f32x4* RED = (LAS f32x4*)(F.lds + RING_OFF);
    LAS float* LRs = (LAS float*)(F.lds + RING_OFF + 65536);
    for (int it = F.hf * (M / 64 / F.nt) + F.tv; it < (F.hf + 1) * (M / 64 / F.nt); it += F.T) {
        const int row0 = it * 64;
        const int c = tid & 255, dir = tid >> 8; float wgr[16];
#pragma unroll
        for (int r = 0; r < 16; ++r) wgr[r] = wg[(dir * 16 + r) * 256 + c];
        const float bgv = bg[dir * 256 + c];
        f32x4 acc[4][2];
#pragma unroll
        for (int mt = 0; mt < 4; ++mt) { acc[mt][0] = (f32x4){0.f, 0.f, 0.f, 0.f}; acc[mt][1] = (f32x4){0.f, 0.f, 0.f, 0.f}; }
#pragma unroll
        for (int ks = 0; ks < 8; ++ks) { const int k = 256 * wave + 32 * ks + 8 * fq;
            const bf16x8 b0 = *(const GAS bf16x8*)(Bt + (size_t)fr * D + k), b1 = *(const GAS bf16x8*)(Bt + (size_t)(16 + fr) * D + k);
#pragma unroll
            for (int mt = 0; mt < 4; ++mt) { const bf16x8 a = *(const GAS bf16x8*)(U + (size_t)(row0 + 16 * mt + fr) * D + k);
                acc[mt][0] = __builtin_amdgcn_mfma_f32_16x16x32_bf16(a, b0, acc[mt][0], 0, 0, 0); acc[mt][1] = __builtin_amdgcn_mfma_f32_16x16x32_bf16(a, b1, acc[mt][1], 0, 0, 0); } }
#pragma unroll
        for (int mt = 0; mt < 4; ++mt) { RED[(wave * 8 + mt * 2 + 0) * 64 + lane] = acc[mt][0]; RED[(wave * 8 + mt * 2 + 1) * 64 + lane] = acc[mt][1]; }
        LDS_BAR();
        { const int tile = tid >> 6, l = tid & 63, mt = tile >> 1, nt = tile & 1; f32x4 s = RED[tile * 64 + l];
#pragma unroll
          for (int w = 1; w < 8; ++w) s += RED[(w * 8 + tile) * 64 + l];
#pragma unroll
          for (int ii = 0; ii < 4; ++ii) LRs[(16 * mt + 4 * (l >> 4) + ii) * 32 + 16 * nt + (l & 15)] = s[ii]; }
        LDS_BAR();
        { float run = 0.f;
          for (int tt0 = 0; tt0 < 64; tt0 += 8) { float la[8];
#pragma unroll
              for (int u = 0; u < 8; ++u) { const int t = dir == 0 ? tt0 + u : 63 - tt0 - u; float s0 = bgv, s1 = 0.f;
#pragma unroll
                  for (int r = 0; r < 16; r += 4) { const f32x4 lr4 = *(const LAS f32x4*)(LRs + t * 32 + dir * 16 + r); s0 += lr4[0] * wgr[r] + lr4[1] * wgr[r + 1]; s1 += lr4[2] * wgr[r + 2] + lr4[3] * wgr[r + 3]; }
                  const float sv = s0 + s1; la[u] = (fminf(sv, 0.f) - __logf(1.0f + __expf(-fabsf(sv)))) * (1.0f / 16.0f); }
#pragma unroll
              for (int u = 0; u < 8; ++u) { const int t = dir == 0 ? tt0 + u : 63 - tt0 - u; run += la[u]; lab[(size_t)(row0 + t) * 512 + dir * 256 + c] = run; } } }
        LDS_BAR();
    }
}
constexpr int NP = 13;
constexpr int PH_FINAL = 1 + DEPTH * NP;
constexpr int PH_END = PH_FINAL + 1;

#define MK_BAR(b, k) XcdBarrier b; b.bar = (unsigned*)WSP(WS_CTL) + CW_BAR + (kargs()->li * 12 + (k)) * XCD_BAR_WORDS; b.x = xb_xcc_id(); b.w0 = (F.wave == 0); b.expect = (unsigned)((k) == 0 ? F.G : (k) >= 10 ? F.G / 2 : (k) >= 2 ? F.G / 8 : F.T); b.st = (volatile LAS unsigned*)((LAS unsigned char*)lds + MISC_OFF) + 8 + 2 * ((k) == 0 ? 0 : (k) >= 10 ? 2 : 1)
#define MIXER_BLOCK(l, pb) \
        if (IN(pb + 5)) { \
            pg8::Gemm g = pg8::mk_gemm((const bf16*)WSP(WS_SUA), (const bf16*)WSP(WS_W1) + (size_t)l * S5_G * 256 * 512, 512, 256, 512); g.lda = 768; g.sA = (size_t)512 * 768; g.sB = (size_t)256 * 512; \
            pg8::BatchOrder S; S.init(512 / F.nt, 256, S5_G, F.T, F.tr); S.pm0 = F.hf * (512 / F.nt / 256); pg8::EpiS5State E{(float*)WSP(WS_SC)}; \
            pg8::gemm_phase<pg8::EpiS5State, pg8::BatchOrder, true, true>(F.lds + RING_OFF, g, S, E, F.wave); \
            if (FAST_MASK & 2) ret_m1_phase(F, RET_ARGS(l)); \
            if (FAST_MASK & 1) chunk_m1_phase<GlaCfg>(F, GLA_ARGS(l), 64 / F.nt); \
            if (PROBE_DUP & 4) { ret_m1_phase(F, RET_ARGS(l)); chunk_m1_phase<GlaCfg>(F, GLA_ARGS(l), 64 / F.nt); } \
            if (PROBE_DUP & 16) { pg8::gemm_phase<pg8::EpiS5State, pg8::BatchOrder, true, true>(F.lds + RING_OFF, g, S, E, F.wave); } \
            if (BOTH(pb + 5)) MIX_BAR(); } \
        if (IN(pb + 6)) { s5_scan_phase(F, l); \
            if (FAST_MASK & 2) ret_scan_phase(F, RET_ARGS(l)); \
            if (FAST_MASK & 1) gla_scan_phase(F, GLA_ARGS(l)); \
            if (BOTH(pb + 6)) MIX_BAR(); } \
        if (IN(pb + 7)) { \
            pg8::Gemm g = pg8::mk_gemm((const bf16*)WSP(WS_SUA), (const bf16*)WSP(WS_MF) + (size_t)l * S5_G * 512 * 768, 512, 512, 768); g.sA = (size_t)512 * 768; g.sB = (size_t)512 * 768; \
            pg8::BatchOrder S; S.init(512 / F.nt, 512, S5_G, F.T, F.tr); S.pm0 = F.hf * (512 / F.nt / 256); pg8::EpiS5Out E{ZP}; \
            pg8::gemm_phase<pg8::EpiS5Out, pg8::BatchOrder, true, true>(F.lds + RING_OFF, g, S, E, F.wave); \
            if (FAST_MASK & 2) ret_m2_phase(F, RET_ARGS(l)); \
            if (FAST_MASK & 1) chunk_m2_phase<GlaCfg, false>(F, GLA_ARGS(l), 128 / F.nt); \
            if (PROBE_DUP & 8) { ret_m2_phase(F, RET_ARGS(l)); chunk_m2_phase<GlaCfg, false>(F, GLA_ARGS(l), 128 / F.nt); } \
            if (PROBE_DUP & 16) { pg8::gemm_phase<pg8::EpiS5Out, pg8::BatchOrder, true, true>(F.lds + RING_OFF, g, S, E, F.wave); } \
            if (BOTH(pb + 7)) MIX_BAR(); }
__global__ void __launch_bounds__(NWAVES * 64, 2) mega(Args args_unused) {
    extern __shared__ __attribute__((aligned(16))) unsigned char lds[];
    Frame F;
    F.lds = (LAS unsigned char*)lds;
    F.MISC = (volatile LAS unsigned*)(F.lds + MISC_OFF);
    F.tid = threadIdx.x; F.lane = F.tid & 63; F.wave = __builtin_amdgcn_readfirstlane(F.tid >> 6);
    F.G = gridDim.x; { const int bx = blockIdx.x; F.vcu = (F.G % 8 == 0) ? (bx % 8) * (F.G / 8) + bx / 8 : bx; }
    { const int bx = blockIdx.x; const bool split = (F.G == 256) && TEAM_SPLIT;
      F.nt = split ? 2 : 1; F.hf = split ? ((bx & 7) >> 2) : 0; F.T = F.G / F.nt; F.tr = split ? (bx >> 3) * 4 + (bx & 3) : bx; F.tv = split ? (bx & 3) * (F.T / 4) + (bx >> 3) : F.vcu; }
    F.ctl = nullptr;
    for (int u = F.tid; u < (LDS_BYTES - LDSCTL_OFF) / 4; u += NWAVES * 64) ((LAS unsigned*)(F.lds + LDSCTL_OFF))[u] = 0u;
    __syncthreads();
    const int lo = kargs()->ph_lo, hi = kargs()->ph_hi;
    const bool lb = LOCAL_BARS && !TEAM_SPLIT && F.G == 256;
    if (hi - lo > 1) { (void)xcd_barrier_post((unsigned*)WSP(WS_CTL) + CW_BAR + (kargs()->li * 12 + 0) * XCD_BAR_WORDS, F.MISC + 8);
                       (void)xcd_barrier_post((unsigned*)WSP(WS_CTL) + CW_BAR + (kargs()->li * 12 + (lb ? 2 + (int)(blockIdx.x & 7) : 1 + F.hf)) * XCD_BAR_WORDS, F.MISC + 10);
                       if (lb) (void)xcd_barrier_post((unsigned*)WSP(WS_CTL) + CW_BAR + (kargs()->li * 12 + 10 + (int)((blockIdx.x & 7) >> 2)) * XCD_BAR_WORDS, F.MISC + 12); }
#define GRID_BAR() do { if (TEAM_SPLIT) { MK_BAR(bar_, 1 + F.hf); xcd_barrier(bar_); } else { MK_BAR(bar_, 0); xcd_barrier(bar_); } } while (0)
#define LOCAL_BAR() do { if (lb) { MK_BAR(bar_, 2 + (int)(blockIdx.x & 7)); xcd_barrier(bar_); } else GRID_BAR(); } while (0)
#define WHOLE_BAR() do { MK_BAR(bar_, 0); xcd_barrier(bar_); } while (0)
#define MIX_BAR() do { if (lb) { MK_BAR(bar_, 10 + (int)((blockIdx.x & 7) >> 2)); xcd_barrier(bar_); } else GRID_BAR(); } while (0)
#define STAGGER() do { if (STAGGER_TICKS > 0) { const unsigned long long t0_ = __builtin_amdgcn_s_memrealtime(), d_ = (unsigned long long)(STAGGER_XCD ? (blockIdx.x & 7) : ((blockIdx.x >> 3) & 31)) * STAGGER_TICKS; while (__builtin_amdgcn_s_memrealtime() - t0_ < d_) __builtin_amdgcn_s_sleep(1); } } while (0)
#define IN(k) (lo <= (k) && (k) < hi)
#define BOTH(k) (IN(k) && IN((k) + 1))
#define LW(l, off) ((const bf16*)(WSP(WS_W) + (size_t)(l) * LW_STRIDE + (off)))
#define MODP(l, k) ((const float*)WSP(WS_MOD) + (size_t)(l) * BATCH * MODW + (k) * D)
#define HP ((h16*)WSP(WS_H))
#define UP ((bf16*)WSP(WS_U))
#define YP ((bf16*)WSP(WS_Y))
#define ZP ((bf16*)WSP(WS_Z))
#define GP ((bf16*)WSP(WS_G2))
#define W2P(l, s) ((const bf16*)WSP(WS_W2P) + (size_t)((l) * 2 + (s)) * D * LDG)
#define PROJP ((bf16*)WSP(WS_PROJ))
#define RET_ARGS(l) (ChunkArgs{PROJP, PC_RQ, PC_RK, PC_RV, PC_RG, (bf16*)WSP(WS_KV_R), (float*)WSP(WS_DEC_R), YP, 0, nullptr, nullptr, nullptr})
#define GLA_ARGS(l) (ChunkArgs{PROJP, PC_GQ, PC_GK, PC_GV, PC_GR, (bf16*)WSP(WS_KV_G), (float*)WSP(WS_DEC_G), YP, 1536, INP(I_WGATE) + (size_t)(l) * 2 * 16 * 256, INP(I_BGATE) + (size_t)(l) * 2 * 256, (const float*)WSP(WS_LA)})

    if (IN(0)) { p0_prologue(F);
#if PROBE_DUP & 1
        WHOLE_BAR(); p0_prologue(F);
#endif
        if (BOTH(0)) { WHOLE_BAR();
            if (F.hf == 1) { const unsigned long long t0 = __builtin_amdgcn_s_memrealtime(); while (__builtin_amdgcn_s_memrealtime() - t0 < 4000ull) __builtin_amdgcn_s_sleep(8); } } }

#pragma clang loop unroll(disable)
    for (int l = 0; l < DEPTH; ++l) {
        const int pb = 1 + l * NP;
        if (pb + NP <= lo || pb >= hi) continue;
        if (IN(pb + 0)) { if (l == 0) norm_mod_phase<false>(F, INP(I_X), INP(I_GFFN1), MODP(0, 0), MODP(0, 1), UP, HP); else norm_mod_phase<true>(F, HP, INP(I_GFFN1) + (size_t)l * D, MODP(l, 0), MODP(l, 1), UP, nullptr); if (BOTH(pb + 0)) LOCAL_BAR(); }
        if (IN(pb + 1)) { STAGGER(); const pg8::Gemm g = pg8::mk_gemm(UP, LW(l, LW_13A), M, 2 * FF, D); pg8::StaticOrder S; S.init(M / F.nt, 2 * FF, F.T, F.tr); S.pm0 = F.hf * (M / F.nt / 256); pg8::EpiSwiGLU E{GP, LDG};
            pg8::gemm_phase<pg8::EpiSwiGLU, pg8::StaticOrder, true, true>(F.lds + RING_OFF, g, S, E, F.wave); if (BOTH(pb + 1)) LOCAL_BAR(); }
        if (IN(pb + 2)) { pg8::Gemm g = pg8::mk_gemm(GP, W2P(l, 0), M, D, FF); g.lda = LDG; g.ldb = LDG; pg8::StaticOrder S; S.init(M / F.nt, D, F.T, F.tr); S.pm0 = F.hf * (M / F.nt / 256); S.alt = (F.T * F.nt == 256); pg8::EpiResid E{HP, HP, D, MODP(l, 2), MODW, 0.5f};
            pg8::gemm_phase<pg8::EpiResid, pg8::StaticOrder, true, true>(F.lds + RING_OFF, g, S, E, F.wave); if (BOTH(pb + 2)) LOCAL_BAR(); }
        if (IN(pb + 3)) { norm_mod_phase<true>(F, HP, INP(I_GMIX) + (size_t)l * D, MODP(l, 3), MODP(l, 4), UP, nullptr); if (BOTH(pb + 3)) LOCAL_BAR(); }
        if (IN(pb + 4)) { const pg8::Gemm g = pg8::mk_gemm(UP, LW(l, LW_IN), M, 5120, D); pg8::StaticOrder S; S.init(M / F.nt, 5120, F.T, F.tr); S.pm0 = F.hf * (M / F.nt / 256); pg8::EpiProj E{PROJP, NINP, (const float*)WSP(WS_ROT), (const float*)WSP(WS_ROT) + SEQ * 64, (bf16*)WSP(WS_SUA)};
            pg8::gemm_phase<pg8::EpiProj, pg8::StaticOrder, true, true>(F.lds + RING_OFF, g, S, E, F.wave);
            lr_phase(F, UP, LW(l, LW_IN) + (size_t)PC_LR * D, INP(I_WGATE) + (size_t)l * 2 * 16 * 256, INP(I_BGATE) + (size_t)l * 2 * 256, (float*)WSP(WS_LA)); if (BOTH(pb + 4)) MIX_BAR(); }
        if (lb) { const int bx = blockIdx.x; F.nt = 2; F.hf = (bx & 7) >> 2; F.T = F.G / 2; F.tr = (bx >> 3) * 4 + (bx & 3); F.tv = (bx & 3) * (F.T / 4) + (bx >> 3); }
        MIXER_BLOCK(l, pb)
        if (lb) { F.nt = 1; F.hf = 0; F.T = F.G; F.tr = (int)blockIdx.x; F.tv = F.vcu; }
#if PROBE_DUP & 2
        GRID_BAR(); MIXER_BLOCK(l, pb)
#endif
        if (IN(pb + 8)) { const pg8::Gemm g = pg8::mk_gemm(ZP, LW(l, LW_GLU), M, S5_W, S5_W); pg8::StaticOrder S; S.init(M / F.nt, S5_W, F.T, F.tr); S.pm0 = F.hf * (M / F.nt / 256); pg8::EpiGlu E{ZP, S5_W, YP, D, 1024, INP(I_BGLU) + (size_t)l * S5_W};
            pg8::gemm_phase<pg8::EpiGlu, pg8::StaticOrder, true, true>(F.lds + RING_OFF, g, S, E, F.wave); if (BOTH(pb + 8)) LOCAL_BAR(); }
        if (IN(pb + 9)) { const pg8::Gemm g = pg8::mk_gemm(YP, LW(l, LW_OUT), M, D, D); pg8::StaticOrder S; S.init(M / F.nt, D, F.T, F.tr); S.pm0 = F.hf * (M / F.nt / 256); S.alt = (F.T * F.nt == 256); pg8::EpiResid E{HP, HP, D, MODP(l, 5), MODW, 1.0f};
            pg8::gemm_phase<pg8::EpiResid, pg8::StaticOrder, true, true>(F.lds + RING_OFF, g, S, E, F.wave); if (BOTH(pb + 9)) LOCAL_BAR(); }
        if (IN(pb + 10)) { norm_mod_phase<true>(F, HP, INP(I_GFFN2) + (size_t)l * D, MODP(l, 6), MODP(l, 7), UP, nullptr); if (BOTH(pb + 10)) LOCAL_BAR(); }
        if (IN(pb + 11)) { STAGGER(); const pg8::Gemm g = pg8::mk_gemm(UP, LW(l, LW_13B), M, 2 * FF, D); pg8::StaticOrder S; S.init(M / F.nt, 2 * FF, F.T, F.tr); S.pm0 = F.hf * (M / F.nt / 256); pg8::EpiSwiGLU E{GP, LDG};
            pg8::gemm_phase<pg8::EpiSwiGLU, pg8::StaticOrder, true, true>(F.lds + RING_OFF, g, S, E, F.wave); if (BOTH(pb + 11)) LOCAL_BAR(); }
        if (IN(pb + 12)) { pg8::Gemm g = pg8::mk_gemm(GP, W2P(l, 1), M, D, FF); g.lda = LDG; g.ldb = LDG; pg8::StaticOrder S; S.init(M / F.nt, D, F.T, F.tr); S.pm0 = F.hf * (M / F.nt / 256); S.alt = (F.T * F.nt == 256); pg8::EpiResid E{HP, HP, D, MODP(l, 8), MODW, 0.5f};
            pg8::gemm_phase<pg8::EpiResid, pg8::StaticOrder, true, true>(F.lds + RING_OFF, g, S, E, F.wave); if (BOTH(pb + 12)) LOCAL_BAR(); }
    }
    if (IN(PH_FINAL)) final_norm_phase(F, HP, INP(I_GFINAL), kargs()->out);
#undef IN
#undef BOTH
#undef GRID_BAR
}

__global__ void __launch_bounds__(512) naive_la(const bf16* proj, const float* wg, const float* bg, float* la) {
    const int m = blockIdx.x, dir = threadIdx.x >> 8, c = threadIdx.x & 255;
    float s = bg[dir * 256 + c];
#pragma unroll
    for (int r = 0; r < GLA_R; ++r) s += bf2f(proj[(size_t)m * NINP + PC_LR + dir * 16 + r]) * wg[(dir * 16 + r) * 256 + c];
    la[((size_t)m * 2 + dir) * 256 + c] = (fminf(s, 0.f) - log1pf(expf(-fabsf(s)))) * (1.0f / 16.0f);
}
template <int DK, int DV, int MODE>
__global__ void __launch_bounds__(256) naive_linrec(const bf16* proj, const float* la, float* o, int dir) {
    constexpr int ES = 32, NE = DV / ES, DPT = DK / 8, TB = 16, NH = 4, OW = NH * DV;
    const int bid = blockIdx.x, es = bid % NE, h = (bid / NE) % NH, b = bid / (NE * NH);
    const int tid = threadIdx.x, e = tid & 31, dg = tid >> 5;
    __shared__ float q_s[TB][DK], k_s[TB][DK], a_s[TB][DK], v_s[TB][ES], red[TB][8][ES];
    constexpr int qoff = MODE == 0 ? PC_RQ : PC_GQ, koff = MODE == 0 ? PC_RK : PC_GK, voff = MODE == 0 ? PC_RV : PC_GV;
    const float gamma = 1.0f - exp2f(-5.0f - (float)h);
    const float scale = MODE == 0 ? 0.08838834764831845f : 0.125f;
    float S[DPT];
#pragma unroll
    for (int i = 0; i < DPT; ++i) S[i] = 0.f;
    for (int bi = 0; bi < SEQ / TB; ++bi) {
        const int t0 = dir == 0 ? bi * TB : SEQ - TB - bi * TB;
        for (int idx = tid; idx < TB * DK; idx += 256) { const int s = idx / DK, d = idx % DK, t = t0 + s; const size_t row = (size_t)(b * SEQ + t);
            q_s[s][d] = bf2f(proj[row * NINP + qoff + h * DK + d]); k_s[s][d] = bf2f(proj[row * NINP + koff + h * DK + d]);
            if (MODE == 1) a_s[s][d] = expf(la[(row * 2 + dir) * 256 + h * DK + d]); }
        for (int idx = tid; idx < TB * ES; idx += 256) { const int s = idx >> 5, ee = idx & 31; v_s[s][ee] = bf2f(proj[(size_t)(b * SEQ + t0 + s) * NINP + voff + h * DV + es * ES + ee]); }
        __syncthreads();
        for (int ss = 0; ss < TB; ++ss) { const int s = dir == 0 ? ss : TB - 1 - ss;
            const float v = v_s[s][e]; float acc = 0.f;
#pragma unroll
            for (int i = 0; i < DPT; ++i) { const int d = dg * DPT + i; const float a = MODE == 0 ? gamma : a_s[s][d];
                const float dec = a * S[i], sn = dec + k_s[s][d] * v; acc += q_s[s][d] * (dir == 0 ? sn : dec); S[i] = sn; }
            red[s][dg][e] = acc; }
        __syncthreads();
        for (int idx = tid; idx < TB * ES; idx += 256) { const int s = idx >> 5, ee = idx & 31; float sum = 0.f;
#pragma unroll
            for (int w = 0; w < 8; ++w) sum += red[s][w][ee];
            float* op = o + (size_t)(b * SEQ + t0 + s) * OW + h * DV + es * ES + ee; if (dir == 0) *op = sum; else *op += sum; }
    }
}
__device__ __forceinline__ float gelu_tanh(float x) { const float u = 0.7978845608028654f * (x + 0.044715f * x * x * x); return 0.5f * x * (1.0f + tanhf(u)); }
__global__ void __launch_bounds__(64) naive_s5(const bf16* proj, const float* lamb, const float* bbar, const float* cre, const float* cim, const float* dsk, float* ys5, bf16* Z) {
    const int g = blockIdx.x % S5_G, b = blockIdx.x / S5_G, p = threadIdx.x;
    __shared__ float u_s[64][16]; __shared__ float part[16][65];
    for (int dir = 0; dir < 2; ++dir) {
        const int gi = (dir * S5_G + g) * S5_P + p;
        const float lr = lamb[2 * gi], li = lamb[2 * gi + 1];
        float Br[16], Bi[16], Cr[16], Ci[16];
#pragma unroll
        for (int c = 0; c < 16; ++c) { Br[c] = bbar[((size_t)gi * 16 + c) * 2]; Bi[c] = bbar[((size_t)gi * 16 + c) * 2 + 1];
            Cr[c] = cre[((size_t)(dir * S5_G + g) * 16 + c) * S5_P + p]; Ci[c] = cim[((size_t)(dir * S5_G + g) * 16 + c) * S5_P + p]; }
        float xr = 0.f, xi = 0.f;
        for (int bi = 0; bi < SEQ / 64; ++bi) {
            const int t0 = dir == 0 ? bi * 64 : SEQ - 64 - bi * 64;
            { const size_t row = (size_t)(b * SEQ + t0 + p) * NINP + PC_SU + g * 16;
#pragma unroll
              for (int c = 0; c < 16; ++c) u_s[p][c] = bf2f(proj[row + c]); }
            __syncthreads();
            for (int ss = 0; ss < 64; ++ss) { const int s = dir == 0 ? ss : 63 - ss;
                float bur = 0.f, bui = 0.f;
#pragma unroll
                for (int c = 0; c < 16; ++c) { const float uv = u_s[s][c]; bur += Br[c] * uv; bui += Bi[c] * uv; }
                const float nr = lr * xr - li * xi + bur, ni = lr * xi + li * xr + bui; xr = nr; xi = ni;
#pragma unroll
                for (int c = 0; c < 16; ++c) part[c][p] = Cr[c] * xr - Ci[c] * xi;
                __syncthreads();
                const int c = p >> 2, q = p & 3; float sm = 0.f;
#pragma unroll
                for (int i = 0; i < 16; ++i) sm += part[c][q * 16 + i];
                sm += __shfl_xor(sm, 1); sm += __shfl_xor(sm, 2);
                if (q == 0) { const size_t idx = (size_t)(b * SEQ + t0 + s) * S5_W + g * 16 + c;
                    if (dir == 0) ys5[idx] = dsk[g * 16 + c] * u_s[s][c] + sm;
                    else { const float y = ys5[idx] + sm; ys5[idx] = y; Z[idx] = (bf16)f2bf(gelu_tanh(y)); } }
                __syncthreads();
            }
        }
    }
}
__global__ void __launch_bounds__(256) naive_post(const bf16* proj, const float* oret, const float* ogla, bf16* Y, int do_ret, int do_gla) {
    const int m = blockIdx.x * 4 + (threadIdx.x >> 6), lane = threadIdx.x & 63;
    for (int h = 0; h < (do_ret ? 4 : 0); ++h) {
        float v[4]; float s = 0.f;
#pragma unroll
        for (int j = 0; j < 4; ++j) { v[j] = oret[(size_t)m * 1024 + h * 256 + j * 64 + lane]; s += v[j]; }
        const float mu = wave_sum(s) * (1.0f / 256.0f); float q = 0.f;
#pragma unroll
        for (int j = 0; j < 4; ++j) { v[j] -= mu; q += v[j] * v[j]; }
        const float rstd = 1.0f / sqrtf(wave_sum(q) * (1.0f / 256.0f) + EPS);
#pragma unroll
        for (int j = 0; j < 4; ++j) { const int c = h * 256 + j * 64 + lane; const float gt = bf2f(proj[(size_t)m * NINP + PC_RG + c]); Y[(size_t)m * D + c] = (bf16)f2bf(gt / (1.0f + expf(-gt)) * v[j] * rstd); }
    }
    for (int h = 0; h < (do_gla ? 4 : 0); ++h) {
        float v[2]; float q = 0.f;
#pragma unroll
        for (int j = 0; j < 2; ++j) { v[j] = ogla[(size_t)m * 512 + h * 128 + j * 64 + lane]; q += v[j] * v[j]; }
        const float rstd = 1.0f / sqrtf(wave_sum(q) * (1.0f / 128.0f) + EPS);
#pragma unroll
        for (int j = 0; j < 2; ++j) { const int c = h * 128 + j * 64 + lane; const float gt = bf2f(proj[(size_t)m * NINP + PC_GR + c]); Y[(size_t)m * D + 1536 + c] = (bf16)f2bf(gt / (1.0f + expf(-gt)) * v[j] * rstd); }
    }
}

static void launch_mega(const Args& base, int lo, int hi, int& li, int grid, hipStream_t stream) {
    Args a = base; a.ph_lo = lo; a.ph_hi = hi; a.li = li++;
    hipLaunchKernelGGL(mega, dim3(grid), dim3(NWAVES * 64), LDS_BYTES, stream, a);
}
extern "C" void kernel_launch(void* const* d_in, const int* in_sizes, int n_in, void* d_out, int out_size, void* d_ws, size_t ws_size, hipStream_t stream) {
    static int grid = 0;
    if (grid == 0) {
        if (n_in != 28 || in_sizes[0] != M * D || out_size != M * D || ws_size < WS_END) { fprintf(stderr, "kernel_launch: unexpected shapes: n_in %d in0 %d out %d ws %zu (need %zu)\n", n_in, n_in > 0 ? in_sizes[0] : -1, out_size, ws_size, (size_t)WS_END); grid = -1; return; }
        int dev = 0, cus = 0, per_cu = 0;
        if (hipGetDevice(&dev) != hipSuccess || hipDeviceGetAttribute(&cus, hipDeviceAttributeMultiprocessorCount, dev) != hipSuccess) { grid = -1; return; }
        if (hipFuncSetAttribute((const void*)mega, hipFuncAttributeMaxDynamicSharedMemorySize, LDS_BYTES) != hipSuccess) { fprintf(stderr, "kernel_launch: hipFuncSetAttribute failed\n"); grid = -1; return; }
        if (hipOccupancyMaxActiveBlocksPerMultiprocessor(&per_cu, (const void*)mega, NWAVES * 64, LDS_BYTES) != hipSuccess || per_cu < 1) fprintf(stderr, "kernel_launch: occupancy query reports %d\n", per_cu);
        (void)hipGetLastError();
        grid = cus;
    }
    if (grid < 0) return;
    hipMemsetAsync((char*)d_ws + WS_CTL, 0, CTL_ZERO_BYTES, stream);
    Args a{};
    for (int i = 0; i < 28; ++i) a.in[i] = (const float*)d_in[i];
    a.out = (float*)d_out; a.ws = (unsigned char*)d_ws;
    unsigned char* ws = (unsigned char*)d_ws;
    int li = 0;
#if MK_MODE == 0
    launch_mega(a, 0, 1, li, grid, stream);
    for (int l = 0; l < DEPTH; ++l) {
        const int pb = 1 + l * NP;
        for (int k = 0; k <= 4; ++k) launch_mega(a, pb + k, pb + k + 1, li, grid, stream);
        const bf16* proj = (const bf16*)(ws + WS_PROJ); float* la = (float*)(ws + WS_LA); float* oret = (float*)(ws + WS_ORET); float* ogla = (float*)(ws + WS_OGLA); float* ys5 = (float*)(ws + WS_YS5);
        if (!(FAST_MASK & 1)) hipLaunchKernelGGL(naive_la, dim3(M), dim3(512), 0, stream, proj, a.in[I_WGATE] + (size_t)l * 2 * 16 * 256, a.in[I_BGATE] + (size_t)l * 2 * 256, la);
        for (int dir = 0; dir < 2; ++dir) {
            if (!(FAST_MASK & 2)) hipLaunchKernelGGL((naive_linrec<128, 256, 0>), dim3(BATCH * 4 * 8), dim3(256), 0, stream, proj, (const float*)la, oret, dir);
            if (!(FAST_MASK & 1)) hipLaunchKernelGGL((naive_linrec<64, 128, 1>), dim3(BATCH * 4 * 4), dim3(256), 0, stream, proj, (const float*)la, ogla, dir);
        }
        for (int kk = 5; kk <= 7; ++kk) launch_mega(a, pb + kk, pb + kk + 1, li, grid, stream);
        if ((FAST_MASK & 3) != 3) hipLaunchKernelGGL(naive_post, dim3(M / 4), dim3(256), 0, stream, proj, (const float*)oret, (const float*)ogla, (bf16*)(ws + WS_Y), (FAST_MASK & 2) ? 0 : 1, (FAST_MASK & 1) ? 0 : 1);
        for (int k = 8; k <= 12; ++k) launch_mega(a, pb + k, pb + k + 1, li, grid, stream);
    }
    launch_mega(a, PH_FINAL, PH_END, li, grid, stream);
#else
    launch_mega(a, 0, PH_END, li, grid, stream);
#endif
}
```
